# Optimizing an MI355X kernel written in HIP

```python
import jax, jax.numpy as jnp
from jax import lax
import numpy as np

D_MODEL = 2048
BATCH = 2
SEQ = 8192
DEPTH = 4

GRID_W = 64
CTX_LEN = 256
D_CONV = D_MODEL // 2
D_ATTN = D_MODEL - D_CONV
HEAD_DIM = 64
N_HEADS = D_ATTN // HEAD_DIM
N_KV_HEADS = 4
GQA_GROUP = N_HEADS // N_KV_HEADS
WINDOW = 128
BLOCK = 128
CONV_WIDTH = 3
D_FF = 4 * D_MODEL
ROPE_THETA = 10000.0
ROPE_AXIS_DIM = HEAD_DIM // 2
EPS = 1e-6
N_MOD = 6
KV_START = 3 * D_CONV + D_ATTN
D_IN_PROJ = KV_START + 2 * N_KV_HEADS * HEAD_DIM
SCALE = HEAD_DIM ** -0.5
NEG_INF = -1e30

kernel_name = "hybrid_conv_swa_dit_block"


def rmsnorm(x, g):
    xf = x.astype(jnp.float32)
    y = xf * lax.rsqrt(jnp.mean(xf * xf, axis=-1, keepdims=True) + EPS)
    return (y * g.astype(jnp.float32)).astype(x.dtype)


def modulate(h, shift, scale):
    return h * (1 + scale) + shift


def short_conv(u, w, b):
    n = u.shape[1]
    up = jnp.pad(u, ((0, 0), (1, 1), (0, 0)))
    return up[:, 0:n] * w[0] + up[:, 1:n + 1] * w[1] + up[:, 2:n + 2] * w[2] + b


def gated_conv_mixer(p_conv, w, b):
    bg, cg, h = jnp.split(p_conv, 3, axis=-1)
    return bg * short_conv(cg * h, w, b)


def rope_tables(n_tokens, dtype):
    rows = n_tokens // GRID_W
    row_pos = jnp.repeat(jnp.arange(rows, dtype=jnp.float32), GRID_W)
    col_pos = jnp.tile(jnp.arange(GRID_W, dtype=jnp.float32), rows)
    inv = ROPE_THETA ** (-jnp.arange(0, ROPE_AXIS_DIM, 2, dtype=jnp.float32) / ROPE_AXIS_DIM)
    ang_r = row_pos[:, None] * inv[None, :]
    ang_c = col_pos[:, None] * inv[None, :]
    return (jnp.cos(ang_r)[:, None, :].astype(dtype), jnp.sin(ang_r)[:, None, :].astype(dtype),
            jnp.cos(ang_c)[:, None, :].astype(dtype), jnp.sin(ang_c)[:, None, :].astype(dtype))


def rotate(x, cos, sin):
    x1, x2 = jnp.split(x, 2, axis=-1)
    return jnp.concatenate([x1 * cos - x2 * sin, x2 * cos + x1 * sin], axis=-1)


def rope_2d(x, tabs):
    cr, sr, cc, sc = tabs
    xr, xc = jnp.split(x, 2, axis=-1)
    return jnp.concatenate([rotate(xr, cr, sr), rotate(xc, cc, sc)], axis=-1)


def band_mask(nb, n_tokens):
    n = jnp.arange(nb)[:, None, None]
    r = jnp.arange(BLOCK)[None, :, None]
    j = jnp.arange(3 * BLOCK)[None, None, :]
    q_pos = n * BLOCK + r
    k_pos = (n - 1) * BLOCK + j
    return (jnp.abs(k_pos - q_pos) <= WINDOW) & (k_pos >= 0) & (k_pos < n_tokens)


def latent_window_attention(q, k, v, kc, vc, sink):
    bsz, n_tok = q.shape[0], q.shape[1]
    n_ctx = kc.shape[1]
    nb = n_tok // BLOCK
    qb = q.reshape(bsz, nb, BLOCK, N_KV_HEADS, GQA_GROUP, HEAD_DIM)

    def band(t):
        tb = t.reshape(bsz, nb, BLOCK, N_KV_HEADS, HEAD_DIM)
        tb = jnp.pad(tb, ((0, 0), (1, 1), (0, 0), (0, 0), (0, 0)))
        return jnp.concatenate([tb[:, :-2], tb[:, 1:-1], tb[:, 2:]], axis=2)

    kw, vw = band(k), band(v)
    s_loc = jnp.einsum('bnqhgd,bnkhd->bnhgqk', qb, kw).astype(jnp.float32) * SCALE
    s_loc = jnp.where(band_mask(nb, n_tok)[None, :, None, None], s_loc, NEG_INF)
    s_ctx = jnp.einsum('bnqhgd,bchd->bnhgqc', qb, kc).astype(jnp.float32) * SCALE
    snk = jnp.broadcast_to(sink.astype(jnp.float32).reshape(1, 1, N_KV_HEADS, GQA_GROUP, 1, 1),
                           s_loc.shape[:-1] + (1,))
    p = jax.nn.softmax(jnp.concatenate([s_loc, s_ctx, snk], axis=-1), axis=-1).astype(v.dtype)
    nk = 3 * BLOCK
    o = (jnp.einsum('bnhgqk,bnkhd->bnqhgd', p[..., :nk], vw)
         + jnp.einsum('bnhgqc,bchd->bnqhgd', p[..., nk:nk + n_ctx], vc))
    return o.reshape(bsz, n_tok, D_ATTN)


def context_attention(qc, kc, vc, sink):
    bsz, n_ctx = qc.shape[0], qc.shape[1]
    qg = qc.reshape(bsz, n_ctx, N_KV_HEADS, GQA_GROUP, HEAD_DIM)
    s = jnp.einsum('blhgd,bchd->bhglc', qg, kc).astype(jnp.float32) * SCALE
    snk = jnp.broadcast_to(sink.astype(jnp.float32).reshape(1, N_KV_HEADS, GQA_GROUP, 1, 1),
                           s.shape[:-1] + (1,))
    p = jax.nn.softmax(jnp.concatenate([s, snk], axis=-1), axis=-1).astype(vc.dtype)
    o = jnp.einsum('bhglc,bchd->blhgd', p[..., :n_ctx], vc)
    return o.reshape(bsz, n_ctx, D_ATTN)


def mixer_merge(conv_out, attn_out, g_oc, g_oa, w_out):
    return jnp.concatenate([rmsnorm(conv_out, g_oc), rmsnorm(attn_out, g_oa)], axis=-1) @ w_out


def sq_relu_mlp(h, w1, w2):
    return jnp.square(jax.nn.relu(h @ w1)) @ w2


def setup_inputs(seed: int = 0) -> dict:
    key = jax.random.key(seed)
    ks = jax.random.split(key, 18)

    def nrm(k, shape, s):
        return jax.random.normal(k, shape, jnp.float32) * s

    return {
        "x": nrm(ks[0], (BATCH, SEQ, D_MODEL), 1.0),
        "c": nrm(ks[1], (BATCH, D_MODEL), 1.0),
        "ctx": nrm(ks[2], (BATCH, CTX_LEN, D_MODEL), 1.0),
        "c_ctx": nrm(ks[3], (D_MODEL,), 1.0),
        "w_ada": nrm(ks[4], (DEPTH, D_MODEL, N_MOD * D_MODEL), 0.5 * D_MODEL ** -0.5),
        "b_ada": nrm(ks[5], (DEPTH, N_MOD * D_MODEL), 0.02),
        "g_norm1": 1.0 + nrm(ks[6], (DEPTH, D_MODEL), 0.02),
        "g_norm2": 1.0 + nrm(ks[7], (DEPTH, D_MODEL), 0.02),
        "w_in": nrm(ks[8], (DEPTH, D_MODEL, D_IN_PROJ), D_MODEL ** -0.5),
        "conv_w": nrm(ks[9], (DEPTH, CONV_WIDTH, D_CONV), CONV_WIDTH ** -0.5),
        "conv_b": nrm(ks[10], (DEPTH, D_CONV), 0.02),
        "sink": nrm(ks[11], (DEPTH, N_HEADS), 0.5),
        "g_out_conv": 1.0 + nrm(ks[12], (DEPTH, D_CONV), 0.02),
        "g_out_attn": 1.0 + nrm(ks[13], (DEPTH, D_ATTN), 0.02),
        "w_out": nrm(ks[14], (DEPTH, D_MODEL, D_MODEL), D_MODEL ** -0.5),
        "w_mlp1": nrm(ks[15], (DEPTH, D_MODEL, D_FF), D_MODEL ** -0.5),
        "w_mlp2": nrm(ks[16], (DEPTH, D_FF, D_MODEL), D_FF ** -0.5),
        "g_final": 1.0 + nrm(ks[17], (D_MODEL,), 0.02),
    }


def reference(x, c, ctx, c_ctx, w_ada, b_ada, g_norm1, g_norm2, w_in, conv_w, conv_b, sink,
              g_out_conv, g_out_attn, w_out, w_mlp1, w_mlp2, g_final):
    bsz, n_tok, _ = x.shape
    n_ctx = ctx.shape[1]
    tabs = rope_tables(n_tok, x.dtype)
    sc = jax.nn.silu(c)
    scc = jax.nn.silu(c_ctx)
    for i in range(DEPTH):
        last = i == DEPTH - 1
        m = jnp.split((sc @ w_ada[i] + b_ada[i])[:, None, :], N_MOD, axis=-1)
        mc = jnp.split(scc @ w_ada[i] + b_ada[i], N_MOD, axis=-1)

        h = modulate(rmsnorm(x, g_norm1[i]), m[0], m[1])
        hc = modulate(rmsnorm(ctx, g_norm1[i]), mc[0], mc[1])
        p = h @ w_in[i]
        p_conv = p[..., :3 * D_CONV]
        q = p[..., 3 * D_CONV:KV_START].reshape(bsz, n_tok, N_HEADS, HEAD_DIM)
        k, v = jnp.split(p[..., KV_START:], 2, axis=-1)
        q = rope_2d(q, tabs)
        k = rope_2d(k.reshape(bsz, n_tok, N_KV_HEADS, HEAD_DIM), tabs)
        v = v.reshape(bsz, n_tok, N_KV_HEADS, HEAD_DIM)
        kc, vc = jnp.split(hc @ w_in[i][:, KV_START:], 2, axis=-1)
        kc = kc.reshape(bsz, n_ctx, N_KV_HEADS, HEAD_DIM)
        vc = vc.reshape(bsz, n_ctx, N_KV_HEADS, HEAD_DIM)

        conv_out = gated_conv_mixer(p_conv, conv_w[i], conv_b[i])
        attn_out = latent_window_attention(q, k, v, kc, vc, sink[i])
        x = x + m[2] * mixer_merge(conv_out, attn_out, g_out_conv[i], g_out_attn[i], w_out[i])

        if not last:
            pc = hc @ w_in[i][:, :KV_START]
            ctx_conv = gated_conv_mixer(pc[..., :3 * D_CONV], conv_w[i], conv_b[i])
            qc = pc[..., 3 * D_CONV:].reshape(bsz, n_ctx, N_HEADS, HEAD_DIM)
            ctx_attn = context_attention(qc, kc, vc, sink[i])
            ctx = ctx + mc[2] * mixer_merge(ctx_conv, ctx_attn, g_out_conv[i], g_out_attn[i], w_out[i])

        x = x + m[5] * sq_relu_mlp(modulate(rmsnorm(x, g_norm2[i]), m[3], m[4]), w_mlp1[i], w_mlp2[i])
        if not last:
            ctx = ctx + mc[5] * sq_relu_mlp(modulate(rmsnorm(ctx, g_norm2[i]), mc[3], mc[4]),
                                            w_mlp1[i], w_mlp2[i])
    return rmsnorm(x, g_final)
```

```cpp
#include <hip/hip_runtime.h>
#include <cstdio>
#include <cstdint>
#include <cmath>
namespace pg8 {
#define PG8_LAS __attribute__((address_space(3)))
typedef unsigned short bf16_t;
typedef short bf16x8 __attribute__((ext_vector_type(8)));
typedef float f32x4 __attribute__((ext_vector_type(4)));
typedef unsigned u32x4 __attribute__((ext_vector_type(4)));
constexpr int BM = 256, BK = 64, HALF = 128, HTB = HALF * BK * 2  , STAGE_BYTES = 8 * HTB, NXCD = 8, WGM = 4;

__host__ __device__ __forceinline__ int lds_byte(int r, int c) { const int st = (r >> 4) * 2 + (c >> 5), rr = r & 15, cc = c & 31, ob = rr * 64 + cc * 2; return st * 1024 + (ob ^ (((ob >> 9) & 1) << 5)); }
__host__ __device__ __forceinline__ void stage_rc(int b, int& R, int& C) { const int st = b / 1024, sb = b % 1024, swz = sb ^ (((sb >> 9) & 1) << 5); R = (st >> 1) * 16 + swz / 64; C = (st & 1) * 32 + (swz % 64) / 2; }
__host__ __device__ __forceinline__ int perm32(int rho) { const int n = rho >> 4, i = rho & 15; return 8 * (i >> 2) + 4 * n + (i & 3); }

struct Unit { int pm, pn, kc; };
struct Gemm { const bf16_t* A; const bf16_t* Bt; int M, N, K, ldk; };

struct StaticOrder {
    int nM, nN, nwg, G, c, pm0;
    __host__ __device__ void init(int M, int N, int G_, int c_, int pm0_ = 0) { nM = M / BM; nN = N / BM; nwg = nM * nN; G = G_; c = c_; pm0 = pm0_; }
    __host__ __device__ bool next(int i, Unit& u) const {
        const long L = (long)i * G + c; if (L >= nwg) return false;
        int wgid = (int)L; { const int q = nwg / NXCD, r = nwg % NXCD, xcd = wgid % NXCD, off = wgid / NXCD; wgid = (xcd < r ? xcd * (q + 1) : r * (q + 1) + (xcd - r) * q) + off; }
        const int nig = WGM * nN, gid = wgid / nig, fm = gid * WGM, gsz = (nM - fm) < WGM ? (nM - fm) : WGM;
        u.pm = pm0 + fm + ((wgid % nig) % gsz); u.pn = (wgid % nig) / gsz; u.kc = 0; return true;
    }
    __device__ __forceinline__ void a_ready(const Unit&) const {}
    __device__ __forceinline__ void done(const Unit&) const {}
};

__device__ __forceinline__ unsigned cvt_pk_bf16(float lo, float hi) { unsigned r; asm volatile("v_cvt_pk_bf16_f32 %0, %1, %2" : "=v"(r) : "v"(lo), "v"(hi)); return r; }
typedef float f32x2 __attribute__((ext_vector_type(2)));
typedef float f32x2 __attribute__((ext_vector_type(2)));

struct NormFold {
    const float* ssqx; const float* bias; int bstride; PG8_LAS float* tab; float inv_n, eps;
    __device__ __forceinline__ void prep(const Unit& u, int& state, int tid) const {
        if (u.pm == state) return;
        state = u.pm;
        const int row = tid >> 1, half = tid & 1;
        float r = 1.0f;
        if (u.pm < 64) {
            const f32x4* q4 = (const f32x4*)(ssqx + (size_t)(u.pm * BM + row) * 32 + half * 16);
            const f32x4 a = q4[0], b = q4[1], c = q4[2], d = q4[3];
            float q = (((a[0] + a[1]) + (a[2] + a[3])) + ((b[0] + b[1]) + (b[2] + b[3]))) + (((c[0] + c[1]) + (c[2] + c[3])) + ((d[0] + d[1]) + (d[2] + d[3])));
            q += __shfl_xor(q, 1);
            r = 1.0f / sqrtf(q * inv_n + eps);
        }
        if (half == 0) tab[row] = r;
        asm volatile("s_waitcnt lgkmcnt(0)" ::: "memory"); __builtin_amdgcn_s_barrier(); asm volatile("" ::: "memory");
    }
};
struct EpiIn {
    static constexpr bool PERM = true, AFTER_DRAIN = false, HAS_MID = false, HAS_PREP = true;
    bf16_t* O; int ldc; const float* rope; float qscale; int n_lat_tiles;
    NormFold nf;
    __device__ __forceinline__ void prep(const Unit& u, int& state, int tid) const { nf.prep(u, state, tid); }
    __device__ __forceinline__ void operator()(const f32x4 (&acc)[2][2][4][2], const Unit& u, int wr, int wc, int fr, int fq) const {
        const int row0 = u.pm * BM + wr * 64 + fr;
        const int obase = u.pn < 4 ? u.pn * BM : (u.pn < 12 ? 1024 + (u.pn - 4) * HALF : (u.pn - 4) * BM);
        const int col0 = obase + wc * 32 + 8 * fq;
        const bool isq = (u.pn >= 12 && u.pn < 16), isk = (u.pn == 16);
        const float sc = isq ? qscale : 1.f;
        const int mi = u.pm < 32 ? 0 : (u.pm < 64 ? 1 : 2);
        const float* bp = nf.bias + (size_t)mi * nf.bstride + u.pn * BM + wc * 32 + 8 * fq;
        f32x4 bv[2][2];
#pragma unroll
        for (int bj = 0; bj < 2; ++bj) { bv[bj][0] = *(const f32x4*)(bp + bj * HALF); bv[bj][1] = *(const f32x4*)(bp + bj * HALF + 4); }
        if ((isq || isk) && u.pm < n_lat_tiles) {
            const int axis = wc & 1;
            f32x4 ecs[4][2];
#pragma unroll
            for (int k = 0; k < 4; ++k) { const int t = (row0 + (axis ? k * 16 : (k & 1) * HALF)) & 8191; const int pos = axis ? (t & 63) : (t >> 6);
                const f32x4* tp = (const f32x4*)(rope + (size_t)(pos * 16 + 4 * fq) * 2); ecs[k][0] = tp[0]; ecs[k][1] = tp[1]; }
#pragma unroll
            for (int ai = 0; ai < 2; ++ai)
#pragma unroll
                for (int m = 0; m < 4; ++m) {
                    const int r = row0 + ai * HALF + m * 16;
                    const float rs = nf.tab[ai * HALF + wr * 64 + m * 16 + fr];
                    const f32x4 cs0 = axis ? ecs[m][0] : ecs[ai][0], cs1 = axis ? ecs[m][1] : ecs[ai][1];
                    bf16_t* rowp = O + (size_t)r * ldc + col0;
#pragma unroll
                    for (int bj = 0; bj < 2; ++bj) {
                        const f32x4 v0 = acc[ai][bj][m][0] * rs + bv[bj][0], v1 = acc[ai][bj][m][1] * rs + bv[bj][1];
                        const float a0 = (v0[0] * cs0[0] - v0[1] * cs0[1]) * sc, b0 = (v0[1] * cs0[0] + v0[0] * cs0[1]) * sc;
                        const float a1 = (v0[2] * cs0[2] - v0[3] * cs0[3]) * sc, b1 = (v0[3] * cs0[2] + v0[2] * cs0[3]) * sc;
                        const float a2 = (v1[0] * cs1[0] - v1[1] * cs1[1]) * sc, b2 = (v1[1] * cs1[0] + v1[0] * cs1[1]) * sc;
                        const float a3 = (v1[2] * cs1[2] - v1[3] * cs1[3]) * sc, b3 = (v1[3] * cs1[2] + v1[2] * cs1[3]) * sc;
                        u32x4 w; w.x = cvt_pk_bf16(a0, b0); w.y = cvt_pk_bf16(a1, b1); w.z = cvt_pk_bf16(a2, b2); w.w = cvt_pk_bf16(a3, b3);
                        *(u32x4*)(rowp + bj * HALF) = w;
                    }
                }
        } else if (u.pn >= 4 && u.pn < 12) {
#pragma unroll
            for (int ai = 0; ai < 2; ++ai)
#pragma unroll
                for (int m = 0; m < 4; ++m) {
                    bf16_t* rowp = O + (size_t)(row0 + ai * HALF + m * 16) * ldc + obase + wc * 32 + 8 * fq;
                    const float rs = nf.tab[ai * HALF + wr * 64 + m * 16 + fr];
                    const f32x4 v0 = acc[ai][0][m][0] * rs + bv[0][0], v1 = acc[ai][0][m][1] * rs + bv[0][1], v2 = acc[ai][1][m][0] * rs + bv[1][0], v3 = acc[ai][1][m][1] * rs + bv[1][1];
                    u32x4 w; w.x = cvt_pk_bf16(v0[0] * v0[1], v0[2] * v0[3]); w.y = cvt_pk_bf16(v1[0] * v1[1], v1[2] * v1[3]); w.z = cvt_pk_bf16(v2[0] * v2[1], v2[2] * v2[3]); w.w = cvt_pk_bf16(v3[0] * v3[1], v3[2] * v3[3]);
                    *(u32x4*)rowp = w;
                }
        } else {
#pragma unroll
            for (int ai = 0; ai < 2; ++ai)
#pragma unroll
                for (int m = 0; m < 4; ++m) {
                    bf16_t* rowp = O + (size_t)(row0 + ai * HALF + m * 16) * ldc + col0;
                    const float rs = nf.tab[ai * HALF + wr * 64 + m * 16 + fr];
#pragma unroll
                    for (int bj = 0; bj < 2; ++bj) {
                        const f32x4 v0 = (acc[ai][bj][m][0] * rs + bv[bj][0]) * sc, v1 = (acc[ai][bj][m][1] * rs + bv[bj][1]) * sc;
                        u32x4 w; w.x = cvt_pk_bf16(v0[0], v0[1]); w.y = cvt_pk_bf16(v0[2], v0[3]); w.z = cvt_pk_bf16(v1[0], v1[1]); w.w = cvt_pk_bf16(v1[2], v1[3]);
                        *(u32x4*)(rowp + bj * HALF) = w;
                    }
                }
        }
    }
};

struct EpiSq {
    static constexpr bool PERM = true, AFTER_DRAIN = false, HAS_MID = false, HAS_PREP = true;
    bf16_t* O; int ldc;
    NormFold nf;
    __device__ __forceinline__ void prep(const Unit& u, int& state, int tid) const { nf.prep(u, state, tid); }
    __device__ __forceinline__ void operator()(const f32x4 (&acc)[2][2][4][2], const Unit& u, int wr, int wc, int fr, int fq) const {
        const int row0 = u.pm * BM + wr * 64 + fr;
        const int col0 = u.pn * BM + wc * 32 + 8 * fq;
        const int mi = u.pm < 32 ? 0 : (u.pm < 64 ? 1 : 2);
        const float* bp = nf.bias + (size_t)mi * nf.bstride + col0;
        f32x4 bv[2][2];
#pragma unroll
        for (int bj = 0; bj < 2; ++bj) { bv[bj][0] = *(const f32x4*)(bp + bj * HALF); bv[bj][1] = *(const f32x4*)(bp + bj * HALF + 4); }
#pragma unroll
        for (int ai = 0; ai < 2; ++ai)
#pragma unroll
            for (int m = 0; m < 4; ++m) {
                bf16_t* rowp = O + (size_t)(row0 + ai * HALF + m * 16) * ldc + col0;
                const float rs = nf.tab[ai * HALF + wr * 64 + m * 16 + fr];
#pragma unroll
                for (int bj = 0; bj < 2; ++bj) {
                    f32x4 v0 = acc[ai][bj][m][0] * rs + bv[bj][0], v1 = acc[ai][bj][m][1] * rs + bv[bj][1];
                    v0 = __builtin_elementwise_max(v0, (f32x4){0.f, 0.f, 0.f, 0.f}); v1 = __builtin_elementwise_max(v1, (f32x4){0.f, 0.f, 0.f, 0.f});
                    v0 = v0 * v0; v1 = v1 * v1;
                    u32x4 w; w.x = cvt_pk_bf16(v0[0], v0[1]); w.y = cvt_pk_bf16(v0[2], v0[3]); w.z = cvt_pk_bf16(v1[0], v1[1]); w.w = cvt_pk_bf16(v1[2], v1[3]);
                    *(u32x4*)(rowp + bj * HALF) = w;
                }
            }
    }
};

template <bool MID> struct EpiRes {
    static constexpr bool PERM = true, AFTER_DRAIN = false, HAS_MID = MID, HAS_PREP = false;
    bf16_t* XA; int ldc; const float* gate; int gstride;
    int mid_t; const PG8_LAS float* tab;
    const float* ginv_old; const float* gs_new; float* ssqx;
    __device__ __forceinline__ void mid(f32x4 (&acc)[2][2][4][2], int ui, int wr, int fr) const {
#pragma unroll
        for (int ai = 0; ai < 2; ++ai)
#pragma unroll
            for (int m = 0; m < 4; ++m) { const float rs = tab[(ui & 1) * 256 + ai * HALF + wr * 64 + m * 16 + fr];
#pragma unroll
                for (int bj = 0; bj < 2; ++bj)
#pragma unroll
                    for (int n = 0; n < 2; ++n) acc[ai][bj][m][n] *= rs; }
    }
    __device__ __forceinline__ void operator()(const f32x4 (&acc)[2][2][4][2], const Unit& u, int wr, int wc, int fr, int fq) const {
        const int mi = u.pm < 32 ? 0 : 1;
        const float* gv = gate + (size_t)mi * gstride;
        const int row0 = u.pm * BM + wr * 64 + fr;
        const int col0 = u.pn * BM + wc * 32 + 8 * fq;
        f32x4 g[2][2], gi[2][2], gn[2][2];
#pragma unroll
        for (int bj = 0; bj < 2; ++bj)
#pragma unroll
            for (int n = 0; n < 2; ++n) { g[bj][n] = *(const f32x4*)(gv + col0 + bj * HALF + 4 * n);
                gi[bj][n] = *(const f32x4*)(ginv_old + (size_t)mi * 2048 + col0 + bj * HALF + 4 * n);
                gn[bj][n] = *(const f32x4*)(gs_new + (size_t)mi * 2048 + col0 + bj * HALF + 4 * n); }
#pragma unroll
        for (int aq = 0; aq < 4; ++aq) { const int ai = aq >> 1, m0 = (aq & 1) * 2;
            u32x4 xv[2][2];
#pragma unroll
            for (int mm = 0; mm < 2; ++mm)
#pragma unroll
                for (int bj = 0; bj < 2; ++bj) xv[mm][bj] = *(const u32x4*)(XA + (size_t)(row0 + ai * HALF + (m0 + mm) * 16) * ldc + col0 + bj * HALF);
#pragma unroll
            for (int mm = 0; mm < 2; ++mm) { const int m = m0 + mm; const size_t ro = (size_t)(row0 + ai * HALF + m * 16) * ldc + col0; float ss = 0.f;
#pragma unroll
                for (int bj = 0; bj < 2; ++bj) { const u32x4 xw = xv[mm][bj];
                    const f32x4 x0 = {__uint_as_float(xw.x << 16), __uint_as_float(xw.x & 0xffff0000u), __uint_as_float(xw.y << 16), __uint_as_float(xw.y & 0xffff0000u)};
                    const f32x4 x1 = {__uint_as_float(xw.z << 16), __uint_as_float(xw.z & 0xffff0000u), __uint_as_float(xw.w << 16), __uint_as_float(xw.w & 0xffff0000u)};
                    const f32x4 o0 = x0 * gi[bj][0] + g[bj][0] * acc[ai][bj][m][0], o1 = x1 * gi[bj][1] + g[bj][1] * acc[ai][bj][m][1];
                    const f32x4 a0 = o0 * gn[bj][0], a1 = o1 * gn[bj][1];
                    u32x4 wa; wa.x = cvt_pk_bf16(a0[0], a0[1]); wa.y = cvt_pk_bf16(a0[2], a0[3]); wa.z = cvt_pk_bf16(a1[0], a1[1]); wa.w = cvt_pk_bf16(a1[2], a1[3]);
                    *(u32x4*)(XA + ro + bj * HALF) = wa;
                    ss += ((o0[0] * o0[0] + o0[1] * o0[1]) + (o0[2] * o0[2] + o0[3] * o0[3])) + ((o1[0] * o1[0] + o1[1] * o1[1]) + (o1[2] * o1[2] + o1[3] * o1[3])); }
                ss += __shfl_xor(ss, 16); ss += __shfl_xor(ss, 32);
                if (fq == 0) ssqx[(size_t)(row0 + ai * HALF + m * 16) * 32 + u.pn * 4 + wc] = ss; }
            asm volatile("" ::: "memory");
        }
    }
};

struct SplitOrder {
    int nM, nN, ks, G, c, pm0;
    __host__ __device__ void init(int pm0_, int nM_, int nN_, int ks_, int G_, int c_) { pm0 = pm0_; nM = nM_; nN = nN_; ks = ks_; G = G_; c = c_; }
    __host__ __device__ bool next(int i, Unit& u) const {
        const long L = (long)i * G + c; const int nt = nM * nN; if (L >= (long)nt * ks) return false;
        const int t = (int)(L % nt); u.kc = (int)(L / nt); u.pm = pm0 + t % nM; u.pn = t / nM; return true;
    }
    __device__ __forceinline__ void a_ready(const Unit&) const {}
    __device__ __forceinline__ void done(const Unit&) const {}
};
struct EpiSlab {
    static constexpr bool PERM = false, AFTER_DRAIN = false, HAS_MID = false, HAS_PREP = false;
    float* slab; int ldc; const float* gv; int pm0; int slab_rows;
    int nscaled; const PG8_LAS float* tab;
    __device__ __forceinline__ void operator()(const f32x4 (&acc)[2][2][4][2], const Unit& u, int wr, int wc, int fr, int fq) const {
        const int row0 = (u.pm - pm0) * BM + wr * 64 + fr;
        const int col0 = u.pn * BM + wc * 32 + 4 * fq;
        float* base = slab + (size_t)u.kc * slab_rows * ldc;
        f32x4 g[2][2];
#pragma unroll
        for (int bj = 0; bj < 2; ++bj)
#pragma unroll
            for (int n = 0; n < 2; ++n) g[bj][n] = *(const f32x4*)(gv + col0 + bj * HALF + n * 16);
#pragma unroll
        for (int ai = 0; ai < 2; ++ai)
#pragma unroll
            for (int m = 0; m < 4; ++m) { float* xp = base + (size_t)(row0 + ai * HALF + m * 16) * ldc + col0;
                const float rs = (u.kc < nscaled) ? tab[ai * HALF + wr * 64 + m * 16 + fr] : 1.0f;
#pragma unroll
                for (int bj = 0; bj < 2; ++bj)
#pragma unroll
                    for (int n = 0; n < 2; ++n) *(f32x4*)(xp + bj * HALF + n * 16) = g[bj][n] * acc[ai][bj][m][n] * rs; }
    }
};

template <class Epi, class Sched, bool ALIGN_EPI = false, bool SP2 = false>
__device__ __forceinline__ void gemm_phase(PG8_LAS unsigned char* lds, const Gemm g, const Sched& S, const Epi& E) {
    int tid_ = threadIdx.x; asm volatile("" : "+v"(tid_));
    const int tid = tid_, wid = __builtin_amdgcn_readfirstlane(tid >> 6), lane = tid & 63, wr = wid >> 2, wc = wid & 3, fr = lane & 15, fq = lane >> 4;
    const int K = g.ldk, nt = g.K / BK; const size_t cstep = (size_t)g.K * 2;
    unsigned voffA[2], voffB[2];
#pragma unroll
    for (int i = 0; i < 2; ++i) { int R, C; stage_rc(tid * 16 + i * 8192, R, C); const int Rb = Epi::PERM ? ((R & ~31) + perm32(R & 31)) : R;
        voffA[i] = (unsigned)(R * K + C) * 2u; voffB[i] = (unsigned)(Rb * K + C) * 2u; }
    const size_t kstep = (size_t)(BK * 2);
    const size_t hstep = (size_t)HALF * K * 2;
    const size_t tstep = 2 * hstep;
    const unsigned ldsw = (unsigned)wid * 1024u;
    const int aoff = lds_byte(wr * 64 + fr, fq * 8), boff = lds_byte(wc * 32 + fr, fq * 8);
#define PG8_SA(b, h) (((b) * 2 + (h)) * HTB)
#define PG8_SB(b, h) ((4 + (b) * 2 + (h)) * HTB)
#define PG8_STAGE(bufoff, gbase, voff) do { _Pragma("unroll") for (int _i = 0; _i < 2; ++_i) \
        __builtin_amdgcn_global_load_lds((const unsigned*)((const char*)(gbase) + (voff)[_i]), (PG8_LAS unsigned*)(lds + (bufoff) + ldsw + _i * 8192), 16, 0, 0); } while (0)
#define PG8_LDA(dst, b, h) do { _Pragma("unroll") for (int m = 0; m < 4; ++m) _Pragma("unroll") for (int k = 0; k < 2; ++k) dst[m][k] = *(const PG8_LAS bf16x8*)(lds + PG8_SA(b, h) + aoff + m * 2048 + k * 1024); } while (0)
#define PG8_LDB(dst, b, h) do { _Pragma("unroll") for (int n = 0; n < 2; ++n) _Pragma("unroll") for (int k = 0; k < 2; ++k) dst[n][k] = *(const PG8_LAS bf16x8*)(lds + PG8_SB(b, h) + boff + n * 2048 + k * 1024); } while (0)
#define PG8_MMA(ai, bj, At, Bt) do { __builtin_amdgcn_s_setprio(1); _Pragma("unroll") for (int m = 0; m < 4; ++m) _Pragma("unroll") for (int n = 0; n < 2; ++n) _Pragma("unroll") for (int k = 0; k < 2; ++k) \
        acc[ai][bj][m][n] = __builtin_amdgcn_mfma_f32_16x16x32_bf16(Bt[n][k], At[m][k], acc[ai][bj][m][n], 0, 0, 0); __builtin_amdgcn_s_setprio(0); } while (0)
#define PG8_WAIT_V(n) asm volatile("s_waitcnt vmcnt(" #n ")" ::: "memory")
#define PG8_WAIT_L(n) asm volatile("s_waitcnt lgkmcnt(" #n ")" ::: "memory")
#define PG8_BAR __builtin_amdgcn_s_barrier()
#define PG8_SCHED __builtin_amdgcn_sched_barrier(0)
    Unit cur, nxt; int ui = 0; int prep_state = -1;
    if (!S.next(0, cur)) return;
    f32x4 acc[2][2][4][2];
#pragma unroll
    for (int a = 0; a < 2; ++a)
#pragma unroll
        for (int b = 0; b < 2; ++b)
#pragma unroll
            for (int m = 0; m < 4; ++m)
#pragma unroll
                for (int n = 0; n < 2; ++n) acc[a][b][m][n] = (f32x4){0.f, 0.f, 0.f, 0.f};
    bf16x8 At[4][2], B0[2][2], B1[2][2];
    const char* cA = (const char*)g.A + (size_t)cur.pm * tstep + (size_t)cur.kc * cstep; const char* cB = (const char*)g.Bt + (size_t)cur.pn * tstep + (size_t)cur.kc * cstep;
    S.a_ready(cur);
    if constexpr (SP2) {
        PG8_STAGE(PG8_SB(0, 0), cB, voffB); PG8_STAGE(PG8_SB(0, 1), cB + hstep, voffB); PG8_STAGE(PG8_SA(0, 0), cA, voffA); PG8_STAGE(PG8_SA(0, 1), cA + hstep, voffA);
        if (wr == 1) PG8_BAR;
        PG8_WAIT_V(2); PG8_BAR;
        PG8_STAGE(PG8_SB(1, 0), cB + kstep, voffB); PG8_STAGE(PG8_SA(1, 0), cA + kstep, voffA); PG8_STAGE(PG8_SB(1, 1), cB + hstep + kstep, voffB);
        PG8_WAIT_V(6); PG8_BAR;
    } else {
        PG8_STAGE(PG8_SB(0, 0), cB, voffB); PG8_STAGE(PG8_SA(0, 0), cA, voffA); PG8_STAGE(PG8_SB(0, 1), cB + hstep, voffB); PG8_STAGE(PG8_SA(0, 1), cA + hstep, voffA);
        if (wr == 1) PG8_BAR;
        PG8_WAIT_V(4); PG8_BAR;
        PG8_STAGE(PG8_SB(1, 0), cB + kstep, voffB); PG8_STAGE(PG8_SA(1, 0), cA + kstep, voffA); PG8_STAGE(PG8_SB(1, 1), cB + hstep + kstep, voffB);
        PG8_WAIT_V(6); PG8_BAR;
    }
    for (;;) {
        const bool has_next = S.next(ui + 1, nxt);
        const char* nA = has_next ? (const char*)g.A + (size_t)nxt.pm * tstep + (size_t)nxt.kc * cstep : cA; const char* nB = has_next ? (const char*)g.Bt + (size_t)nxt.pn * tstep + (size_t)nxt.kc * cstep : cB;
        for (int t = 0; t < nt; t += 2) {
            const bool last = (t == nt - 2);
            const char* a1 = cA + (size_t)(t + 1) * kstep;
            const char* a2 = last ? nA : cA + (size_t)(t + 2) * kstep; const char* b2 = last ? nB : cB + (size_t)(t + 2) * kstep;
            const char* a3 = a2 + kstep; const char* b3 = b2 + kstep;
            if (last && has_next) S.a_ready(nxt);
            if constexpr (Epi::HAS_MID) { if (t == E.mid_t) E.mid(acc, ui, wr, fr); }
            if constexpr (SP2) {
            PG8_LDB(B0, 0, 0); PG8_LDB(B1, 0, 1); PG8_SCHED; PG8_LDA(At, 0, 0); PG8_STAGE(PG8_SA(1, 1), a1 + hstep, voffA);
            PG8_WAIT_V(8); PG8_WAIT_L(0); PG8_BAR; PG8_MMA(0, 0, At, B0); PG8_MMA(0, 1, At, B1); PG8_BAR; PG8_SCHED;
            PG8_LDA(At, 0, 1); PG8_STAGE(PG8_SB(0, 0), b2, voffB); PG8_STAGE(PG8_SB(0, 1), b2 + hstep, voffB); PG8_STAGE(PG8_SA(0, 0), a2, voffA);
            PG8_WAIT_V(8); PG8_WAIT_L(0); PG8_BAR; PG8_MMA(1, 0, At, B0); PG8_MMA(1, 1, At, B1); PG8_BAR; PG8_SCHED;
            PG8_LDB(B0, 1, 0); PG8_LDB(B1, 1, 1); PG8_SCHED; PG8_LDA(At, 1, 0); PG8_STAGE(PG8_SA(0, 1), a2 + hstep, voffA);
            PG8_WAIT_V(8); PG8_WAIT_L(0); PG8_BAR; PG8_MMA(0, 0, At, B0); PG8_MMA(0, 1, At, B1); PG8_BAR; PG8_SCHED;
            PG8_LDA(At, 1, 1); PG8_STAGE(PG8_SB(1, 0), b3, voffB); PG8_STAGE(PG8_SB(1, 1), b3 + hstep, voffB); PG8_STAGE(PG8_SA(1, 0), a3, voffA);
            PG8_WAIT_V(8); PG8_WAIT_L(0); PG8_BAR; PG8_MMA(1, 0, At, B0); PG8_MMA(1, 1, At, B1); PG8_BAR; PG8_SCHED;
            } else {
            PG8_LDB(B0, 0, 0); PG8_SCHED; PG8_LDA(At, 0, 0); PG8_STAGE(PG8_SA(1, 1), a1 + hstep, voffA);
            PG8_WAIT_L(8); PG8_BAR; PG8_WAIT_L(0); PG8_MMA(0, 0, At, B0); PG8_BAR; PG8_SCHED;
            PG8_LDB(B1, 0, 1); PG8_STAGE(PG8_SB(0, 0), b2, voffB);
            PG8_BAR; PG8_WAIT_L(0); PG8_MMA(0, 1, At, B1); PG8_BAR;
            PG8_LDA(At, 0, 1); PG8_STAGE(PG8_SA(0, 0), a2, voffA);
            PG8_BAR; PG8_WAIT_L(0); PG8_MMA(1, 0, At, B0); PG8_BAR; PG8_SCHED;
            PG8_STAGE(PG8_SB(0, 1), b2 + hstep, voffB);
            PG8_WAIT_V(6); PG8_BAR; PG8_MMA(1, 1, At, B1); PG8_BAR;
            PG8_LDB(B0, 1, 0); PG8_SCHED; PG8_LDA(At, 1, 0); PG8_STAGE(PG8_SA(0, 1), a2 + hstep, voffA);
            PG8_WAIT_L(8); PG8_BAR; PG8_WAIT_L(0); PG8_MMA(0, 0, At, B0); PG8_BAR; PG8_SCHED;
            PG8_LDB(B1, 1, 1); PG8_STAGE(PG8_SB(1, 0), b3, voffB);
            PG8_BAR; PG8_WAIT_L(0); PG8_MMA(0, 1, At, B1); PG8_BAR;
            PG8_LDA(At, 1, 1); PG8_STAGE(PG8_SA(1, 0), a3, voffA);
            PG8_BAR; PG8_WAIT_L(0); PG8_MMA(1, 0, At, B0); PG8_BAR; PG8_SCHED;
            PG8_STAGE(PG8_SB(1, 1), b3 + hstep, voffB);
            PG8_WAIT_V(6); PG8_BAR; PG8_MMA(1, 1, At, B1); PG8_BAR;
            }
        }
        if constexpr (ALIGN_EPI) { if (wr == 0) PG8_BAR; }
        if constexpr (Epi::HAS_PREP) { static_assert(ALIGN_EPI, "prep() holds a workgroup barrier: both halves must be aligned"); E.prep(cur, prep_state, tid); }
        if constexpr (!Epi::AFTER_DRAIN) { E(acc, cur, wr, wc, fr, fq); S.done(cur); }
        if (!has_next) break;
#pragma unroll
        for (int a = 0; a < 2; ++a)
#pragma unroll
            for (int b = 0; b < 2; ++b)
#pragma unroll
                for (int m = 0; m < 4; ++m)
#pragma unroll
                    for (int n = 0; n < 2; ++n) acc[a][b][m][n] = (f32x4){0.f, 0.f, 0.f, 0.f};
        cur = nxt; cA = nA; cB = nB; ++ui;
        if constexpr (ALIGN_EPI) { if (wr == 1) PG8_BAR; }
    }
    PG8_WAIT_V(0);
    if constexpr (!ALIGN_EPI) { if (wr == 0) PG8_BAR; }
    PG8_BAR;
    if constexpr (Epi::AFTER_DRAIN) { E.fused(acc, cur, wr, wc, fr, fq, lds, wid, lane); S.done(cur); }
#undef PG8_SA
#undef PG8_SB
#undef PG8_STAGE
#undef PG8_LDA
#undef PG8_LDB
#undef PG8_MMA
#undef PG8_WAIT_V
#undef PG8_WAIT_L
#undef PG8_BAR
#undef PG8_SCHED
}
}
#include <hip/hip_bf16.h>
namespace attp {
using bf16=__hip_bfloat16;
using bf16x8=__attribute__((ext_vector_type(8)))short;
using s16x4=__attribute__((ext_vector_type(4)))short;
using f32x16=__attribute__((ext_vector_type(16)))float;
using u32x4=__attribute__((ext_vector_type(4)))unsigned;
constexpr int D=64,PITCH=3584,QCOL=2048,KCOL=3072,VCOL=3328,MGP=2048;
constexpr int NW=8,QBLK=32,KVBLK=64;
__device__ __forceinline__ int crow(int r,int hi){return (r&3)+8*(r>>2)+4*hi;}
#define SBAR() __builtin_amdgcn_sched_barrier(0)
__device__ __forceinline__ void bmask(f32x16&p0,f32x16&p1,int jb,int qrel,int hi){
  const float NEG=-INFINITY; const int base=64*jb-qrel+4*hi;
  #pragma unroll
  for(int r=0;r<16;++r){const int d=base+(r&3)+8*(r>>2); if(d<0||d>256)p0[r]=NEG; if(d+32<0||d+32>256)p1[r]=NEG;}
}
constexpr int NSLOT=3, SLOTB=8192;
constexpr int LDS_K=0, LDS_V=NSLOT*SLOTB, LDS_WS=2*NSLOT*SLOTB, LDS_OST=LDS_WS+NW*64*4, LDS_BYTES=LDS_OST+NW*4096;
constexpr float C2=0.125f*1.4426950408889634f;
__device__ __forceinline__ void glds16(const void*gsrc,unsigned lds_dst){unsigned keep;
  asm volatile("s_mov_b32 %0, m0\n\ts_mov_b32 m0, %2\n\ts_nop 0\n\tglobal_load_lds_dwordx4 %1, off\n\ts_mov_b32 m0, %0":"=&s"(keep):"v"(gsrc),"s"(lds_dst):"memory");}
__device__ __forceinline__ float max3f(float a,float b,float c){float r;asm("v_max3_f32 %0, %1, %2, %3":"=v"(r):"v"(a),"v"(b),"v"(c));return r;}
__device__ __forceinline__ float max2f(float a,float b){float r;asm("v_max_f32_e32 %0, %1, %2":"=v"(r):"v"(a),"v"(b));return r;}
__device__ __forceinline__ float fadd_s(float a,float b){float r;asm("v_add_f32_e32 %0, %1, %2":"=v"(r):"v"(a),"v"(b));return r;}
__device__ __forceinline__ float fsub_s(float a,float b){float r;asm("v_sub_f32_e32 %0, %1, %2":"=v"(r):"v"(a),"v"(b));return r;}
typedef float f32x2_t __attribute__((ext_vector_type(2))); typedef __bf16 bf16x2_t __attribute__((ext_vector_type(2)));
__device__ __forceinline__ unsigned cvtpk_s(float lo,float hi){f32x2_t v={lo,hi};bf16x2_t b=__builtin_convertvector(v,bf16x2_t);return __builtin_bit_cast(unsigned,b);}
#define WAIT_BAR(N) asm volatile("s_waitcnt vmcnt(" #N ") lgkmcnt(0)\n\ts_barrier":::"memory")

__device__ __forceinline__ void qkt(f32x16&p0,f32x16&p1,const char*Kslot,const bf16x8*qr,const f32x16&negm,int r32,int hi){
  const char*kb=Kslot+hi*1024+r32*16;
  #pragma unroll
  for(int d0=0;d0<4;++d0){
    const bf16x8 b0=*reinterpret_cast<const bf16x8*>(kb+d0*2048);
    const bf16x8 b1=*reinterpret_cast<const bf16x8*>(kb+d0*2048+512);
    if(d0==0){p0=__builtin_amdgcn_mfma_f32_32x32x16_bf16(b0,qr[0],negm,0,0,0);p1=__builtin_amdgcn_mfma_f32_32x32x16_bf16(b1,qr[0],negm,0,0,0);}
    else{p0=__builtin_amdgcn_mfma_f32_32x32x16_bf16(b0,qr[d0],p0,0,0,0);p1=__builtin_amdgcn_mfma_f32_32x32x16_bf16(b1,qr[d0],p1,0,0,0);}}
}
typedef __attribute__((address_space(3))) const char* lds_cptr;
typedef short v4i16_t __attribute__((ext_vector_type(4)));
__device__ __forceinline__ void kload8(bf16x8*kf,lds_cptr kp){
  kf[0]=*(const __attribute__((address_space(3))) bf16x8*)(kp);      kf[1]=*(const __attribute__((address_space(3))) bf16x8*)(kp+512);
  kf[2]=*(const __attribute__((address_space(3))) bf16x8*)(kp+2048); kf[3]=*(const __attribute__((address_space(3))) bf16x8*)(kp+2560);
  kf[4]=*(const __attribute__((address_space(3))) bf16x8*)(kp+4096); kf[5]=*(const __attribute__((address_space(3))) bf16x8*)(kp+4608);
  kf[6]=*(const __attribute__((address_space(3))) bf16x8*)(kp+6144); kf[7]=*(const __attribute__((address_space(3))) bf16x8*)(kp+6656);
}
__device__ __forceinline__ void kload2(bf16x8*kf,lds_cptr kp,int j){ kf[2*j]=*(const __attribute__((address_space(3))) bf16x8*)(kp+j*2048); kf[2*j+1]=*(const __attribute__((address_space(3))) bf16x8*)(kp+j*2048+512); }
__device__ __forceinline__ s16x4 vtr(lds_cptr p){ return __builtin_bit_cast(s16x4,__builtin_amdgcn_ds_read_tr16_b64_v4i16((__attribute__((address_space(3))) v4i16_t*)p)); }
__device__ __forceinline__ float rowmax(const f32x16&p0,const f32x16&p1){
  float a=max3f(p0[0],p0[1],p1[0]),b=max3f(p0[2],p0[3],p1[1]);a=max3f(a,p1[2],p1[3]);
  #pragma unroll
  for(int r=4;r<16;r+=4){a=max3f(a,p0[r],p0[r+1]);b=max3f(b,p0[r+2],p0[r+3]);a=max3f(a,p1[r],p1[r+1]);b=max3f(b,p1[r+2],p1[r+3]);}
  const float m=max2f(a,b);
  auto rr=__builtin_amdgcn_permlane32_swap(__float_as_uint(m),__float_as_uint(m),false,false);
  return max2f(__uint_as_float(rr[0]),__uint_as_float(rr[1]));
}
__device__ __forceinline__ void pv(f32x16*o,int vb,bf16x8 pa0,bf16x8 pa1,bf16x8 pa2,bf16x8 pa3){
  #pragma unroll
  for(int d0=0;d0<2;++d0){s16x4 lo[4],hi[4];
    #pragma unroll
    for(int ks=0;ks<4;++ks){
      asm volatile("ds_read_b64_tr_b16 %0,%1 offset:%c2":"=&v"(lo[ks]):"v"(vb),"i"(d0*4096+ks*1024):"memory");
      asm volatile("ds_read_b64_tr_b16 %0,%1 offset:%c2":"=&v"(hi[ks]):"v"(vb),"i"(d0*4096+ks*1024+512):"memory");}
    asm volatile("s_waitcnt lgkmcnt(0)":::"memory");SBAR();
    #define PK(k) (bf16x8){lo[k][0],lo[k][1],lo[k][2],lo[k][3],hi[k][0],hi[k][1],hi[k][2],hi[k][3]}
    o[d0]=__builtin_amdgcn_mfma_f32_32x32x16_bf16(pa0,PK(0),o[d0],0,0,0);
    o[d0]=__builtin_amdgcn_mfma_f32_32x32x16_bf16(pa1,PK(1),o[d0],0,0,0);
    o[d0]=__builtin_amdgcn_mfma_f32_32x32x16_bf16(pa2,PK(2),o[d0],0,0,0);
    o[d0]=__builtin_amdgcn_mfma_f32_32x32x16_bf16(pa3,PK(3),o[d0],0,0,0);
    #undef PK
  }
}

#ifndef ATTN_STORE16
#define ATTN_STORE16(p,v) (*(u32x4*)(p)=(v))
#endif
struct UnitDesc { int qrow0, hq0, kvh, ctxrow0, bandrow0, jb_lo, jb_hi; };
template<int THRL> __device__ __forceinline__ void attn_unit(const UnitDesc ud,const UnitDesc udn,const bool has_next,const bool pref,bf16x8 (&qr)[4],const bf16*Pb,bf16*MG,float*SSQ,const __attribute__((address_space(3))) float*sink_l2,char*shm){
  int tid_=threadIdx.x; asm volatile("":"+v"(tid_)); const int tid=tid_,lane=tid&63,r32=lane&31,hi=lane>>5; const int wid=__builtin_amdgcn_readfirstlane(tid>>6);
  const int hq=ud.hq0+(wid>>1);
  const bf16*Qw=Pb+(long)(ud.qrow0+(wid&1)*QBLK)*PITCH+QCOL+hq*D;
  const bf16*Kh=Pb+KCOL+ud.kvh*D,*Vh=Pb+VCOL+ud.kvh*D;
  const unsigned lds0=(unsigned)(uintptr_t)shm;
  float*wsf=(float*)(shm+LDS_WS)+wid*64;
  const bf16*ksrc=Kh+(long)lane*PITCH+wid*8;
  const bf16*vsrc=Vh+(long)(16*(wid&3)+(lane>>2))*PITCH+(wid>>2)*32+(lane&3)*8;
  const unsigned kdst=lds0+LDS_K+wid*1024, vdst=lds0+LDS_V+wid*1024;
  const int nb_=ud.jb_hi-ud.jb_lo;
  const int jb_u0=ud.jb_lo>1?ud.jb_lo:1, nun_=(ud.jb_hi<4?ud.jb_hi:4)-jb_u0;
  #define JBF(i) ((i)<nun_?jb_u0+(i):((ud.jb_lo==0&&(i)==nun_)?0:4))
  #define KROW(t) ((long)((t)<4?ud.ctxrow0+64*(t):ud.bandrow0+64*JBF((t)-4)))
  #define DMA_K(t,slot) glds16(ksrc+KROW(t)*PITCH,(unsigned)__builtin_amdgcn_readfirstlane(kdst+(slot)))
  #define DMA_V(t,slot) glds16(vsrc+KROW(t)*PITCH,(unsigned)__builtin_amdgcn_readfirstlane(vdst+(slot)))
  const int vb0=(int)(lds0+LDS_V)+((lane>>4)&1)*32+(lane&3)*8+(4*hi+((lane&15)>>2))*64;
  const char*Kbase=shm+LDS_K; bf16x8 kf[8];
  const lds_cptr shm3=(lds_cptr)shm; const lds_cptr kp0=shm3+LDS_K+hi*1024+r32*16; const lds_cptr vp0=shm3+LDS_V+((lane>>4)&1)*32+(lane&3)*8+(4*hi+((lane&15)>>2))*64;
  const int NT=4+nb_;
  const bool domask=nb_>0;
  if(!pref){
  DMA_K(0,0);DMA_V(0,0);DMA_K(1,SLOTB);
  #pragma unroll
  for(int d0=0;d0<4;++d0)qr[d0]=*reinterpret_cast<const bf16x8*>(&Qw[(long)r32*PITCH+d0*16+hi*8]);
  }
  float mhat=0.f,l_reg=0.f;f32x16 o[2];o[0]=f32x16{};o[1]=f32x16{};f32x16 negm=f32x16{};asm volatile("":"+v"(negm));
  const int qrel=(wid&1)*QBLK+r32;
  #define CMASK(P0,P1,t) do{ if(domask && (t)>=4+nun_) bmask(P0,P1,JBF((t)-4),qrel,hi); }while(0)
  bool resc=false;
  #define START(P0,P1) do{ const float rm=rowmax(P0,P1); resc=false; \
    { const float dl=rm; mhat=fadd_s(mhat,dl); \
      _Pragma("unroll") for(int r=0;r<16;++r){P0[r]=fsub_s(P0[r],dl);P1[r]=fsub_s(P1[r],dl);} \
      _Pragma("unroll") for(int r=0;r<16;++r)negm[r]=-mhat; asm volatile("":"+v"(negm)); } \
    _Pragma("unroll") for(int r=0;r<16;++r)P0[r]=__builtin_amdgcn_exp2f(P0[r]); }while(0)
  #define RESC() do{ if(resc){ asm volatile("s_waitcnt lgkmcnt(0)":::"memory"); \
      _Pragma("unroll") for(int d_=0;d_<2;++d_) _Pragma("unroll") for(int r=0;r<16;++r)o[d_][r]*=wsf[crow(r,hi)]; } }while(0)
  f32x16 pA0,pA1,pB0,pB1;
  int sl_prev=0,sl_cur=0,sl_next=SLOTB;
  #define ROT() do{sl_prev=sl_cur;sl_cur=sl_next;sl_next=(sl_next==(NSLOT-1)*SLOTB)?0:sl_next+SLOTB;}while(0)
  if(!pref){
  DMA_K(2,2*SLOTB);
  WAIT_BAR(3);
  asm volatile("":"+v"(qr[0]),"+v"(qr[1]),"+v"(qr[2]),"+v"(qr[3]));
  } else {
  WAIT_BAR(8);
  }
  qkt(pA0,pA1,Kbase,qr,negm,r32,hi);asm volatile("s_nop 15\n\ts_nop 7":"+v"(pA0),"+v"(pA1));CMASK(pA0,pA1,0);
  START(pA0,pA1);
  _Pragma("unroll") for(int r=0;r<16;++r)pA1[r]=__builtin_amdgcn_exp2f(pA1[r]);
  WAIT_BAR(0);
  DMA_K(3,0);DMA_V(1,SLOTB);
  ROT();
  kload8(kf,kp0+sl_cur);
  WAIT_BAR(2);
  s16x4 vlo[8],vhi[8]; u32x4 pw0,pw1,pw2,pw3;
  #define PKW(P,B) cvtpk_s(P[B],P[B+1])
  #define PAF(k) __builtin_bit_cast(bf16x8,pw##k)
  #define VFR(i) (bf16x8){vlo[i][0],vlo[i][1],vlo[i][2],vlo[i][3],vhi[i][0],vhi[i][1],vhi[i][2],vhi[i][3]}
  #define PIN(x) asm volatile("":"+v"(x))
  #define MX3(a,b,c) __builtin_fmaxf(__builtin_fmaxf((a),(b)),(c))
  #define GAPA(MF,A0,A1,A2,A3,W0,W1,PW) do{ MF; sacc+=A0; sacc+=A1; sacc+=A2; sacc+=A3; PIN(sacc); W0; W1; PIN(PW); SBAR(); }while(0)
  #define EX(v) __builtin_amdgcn_exp2f(v)
  #define GAPB(MF,X,B) do{ MF; X[B]=EX(X[B]); X[B+1]=EX(X[B+1]); X[B+2]=EX(X[B+2]); X[B+3]=EX(X[B+3]); PIN(X); SBAR(); }while(0)
  #define VRD(i) do{ vlo[i]=vtr(vp_+(((i)>>2)*4096+((i)&3)*1024)); vhi[i]=vtr(vp_+(((i)>>2)*4096+((i)&3)*1024+512)); }while(0)
  #define KRD(G,j) do{ if(G){ kload2(kf,kp0+sl_next,j); SBAR(); } }while(0)
  #define STEP(C0,C1,P0,P1,t,GK,GV,GL) do{ SBAR(); \
    const lds_cptr vp_=vp0+sl_prev; \
    VRD(0); SBAR(); float sacc=(P0[0]+P0[1]); \
    GAPA(C0=__builtin_amdgcn_mfma_f32_32x32x16_bf16(kf[0],qr[0],negm,0,0,0), P0[2],P0[3],P0[4],P0[5],     pw0[0]=PKW(P0,0), pw0[1]=PKW(P0,2), pw0); \
    VRD(4); SBAR(); GAPA(C1=__builtin_amdgcn_mfma_f32_32x32x16_bf16(kf[1],qr[0],negm,0,0,0), P0[6],P0[7],P0[8],P0[9],     pw0[2]=PKW(P0,4), pw0[3]=PKW(P0,6), pw0); \
    VRD(1); SBAR(); GAPA(C0=__builtin_amdgcn_mfma_f32_32x32x16_bf16(kf[2],qr[1],C0,0,0,0),   P0[10],P0[11],P0[12],P0[13], pw1[0]=PKW(P0,8), pw1[1]=PKW(P0,10), pw1); \
    VRD(5); SBAR(); GAPA(C1=__builtin_amdgcn_mfma_f32_32x32x16_bf16(kf[3],qr[1],C1,0,0,0),   P0[14],P0[15],P1[0],P1[1],   pw1[2]=PKW(P0,12),pw1[3]=PKW(P0,14), pw1); \
    VRD(2); SBAR(); GAPA(C0=__builtin_amdgcn_mfma_f32_32x32x16_bf16(kf[4],qr[2],C0,0,0,0),   P1[2],P1[3],P1[4],P1[5],     pw2[0]=PKW(P1,0), pw2[1]=PKW(P1,2), pw2); \
    VRD(6); SBAR(); GAPA(C1=__builtin_amdgcn_mfma_f32_32x32x16_bf16(kf[5],qr[2],C1,0,0,0),   P1[6],P1[7],P1[8],P1[9],     pw2[2]=PKW(P1,4), pw2[3]=PKW(P1,6), pw2); \
    VRD(3); SBAR(); GAPA(C0=__builtin_amdgcn_mfma_f32_32x32x16_bf16(kf[6],qr[3],C0,0,0,0),   P1[10],P1[11],P1[12],P1[13], pw3[0]=PKW(P1,8), pw3[1]=PKW(P1,10), pw3); \
    VRD(7); SBAR(); GAPA(C1=__builtin_amdgcn_mfma_f32_32x32x16_bf16(kf[7],qr[3],C1,0,0,0),   P1[14],P1[15],0.f,0.f,       pw3[2]=PKW(P1,12),pw3[3]=PKW(P1,14), pw3); \
    l_reg+=sacc; \
    if(GK){DMA_K((t)+3,sl_cur);} if(GV){DMA_V((t)+1,sl_next);} \
    CMASK(C0,C1,t); \
    { float a=MX3(C0[0],C0[1],C1[0]),b=MX3(C0[2],C0[3],C1[1]); a=MX3(a,C1[2],C1[3]); \
      _Pragma("unroll") for(int r=4;r<16;r+=4){a=MX3(a,C0[r],C0[r+1]);b=MX3(b,C0[r+2],C0[r+3]);a=MX3(a,C1[r],C1[r+1]);b=MX3(b,C1[r+2],C1[r+3]);} \
      float rm=__builtin_fmaxf(a,b); { auto rr=__builtin_amdgcn_permlane32_swap(__float_as_uint(rm),__float_as_uint(rm),false,false); rm=__builtin_fmaxf(__uint_as_float(rr[0]),__uint_as_float(rr[1])); } \
      resc=false; \
      if(__builtin_expect(__any(rm>(float)THRL),0)){ const float dl=__builtin_fmaxf(rm,0.f); mhat+=dl; \
        _Pragma("unroll") for(int r=0;r<16;++r){C0[r]-=dl;C1[r]-=dl;} \
        _Pragma("unroll") for(int r=0;r<16;++r)negm[r]=-mhat; asm volatile("":"+v"(negm)); \
        const float f=__builtin_amdgcn_exp2f(-dl); l_reg*=f; if(hi==0)wsf[r32]=f; resc=true; } } \
    SBAR(); \
    GAPB(o[0]=__builtin_amdgcn_mfma_f32_32x32x16_bf16(PAF(0),VFR(0),o[0],0,0,0), C0,0); \
    GAPB(o[1]=__builtin_amdgcn_mfma_f32_32x32x16_bf16(PAF(0),VFR(4),o[1],0,0,0), C0,4); \
    KRD(GL,0); GAPB(o[0]=__builtin_amdgcn_mfma_f32_32x32x16_bf16(PAF(1),VFR(1),o[0],0,0,0), C0,8); \
    KRD(GL,1); GAPB(o[1]=__builtin_amdgcn_mfma_f32_32x32x16_bf16(PAF(1),VFR(5),o[1],0,0,0), C0,12); \
    KRD(GL,2); GAPB(o[0]=__builtin_amdgcn_mfma_f32_32x32x16_bf16(PAF(2),VFR(2),o[0],0,0,0), C1,0); \
    KRD(GL,3); GAPB(o[1]=__builtin_amdgcn_mfma_f32_32x32x16_bf16(PAF(2),VFR(6),o[1],0,0,0), C1,4); \
    GAPB(o[0]=__builtin_amdgcn_mfma_f32_32x32x16_bf16(PAF(3),VFR(3),o[0],0,0,0), C1,8); \
    GAPB(o[1]=__builtin_amdgcn_mfma_f32_32x32x16_bf16(PAF(3),VFR(7),o[1],0,0,0), C1,12); \
    }while(0)
  int t=1;
  #undef CMASK
  #define CMASK(P0,P1,t) do{}while(0)
  for(;t+4<NT&&t+1<4+nun_;t+=2){
    STEP(pB0,pB1,pA0,pA1,t,true,true,true);     WAIT_BAR(2); RESC(); ROT();
    STEP(pA0,pA1,pB0,pB1,t+1,true,true,true);   WAIT_BAR(2); RESC(); ROT();
  }
  #undef CMASK
  #define CMASK(P0,P1,t) do{ if(domask && (t)>=4+nun_) bmask(P0,P1,JBF((t)-4),qrel,hi); }while(0)
  #define ENDW(tt) do{ if((tt)+3<NT){WAIT_BAR(2);} else if((tt)+2<NT){WAIT_BAR(1);} else {WAIT_BAR(0);} }while(0)
  for(;t+2<NT;t+=2){
    STEP(pB0,pB1,pA0,pA1,t,(t+3<NT),(t+1<NT),(t+1<NT));       ENDW(t);   RESC(); ROT();
    STEP(pA0,pA1,pB0,pB1,t+1,(t+4<NT),(t+2<NT),(t+2<NT));     ENDW(t+1); RESC(); ROT();
  }
  #define DRAIN(Q0,Q1) do{ float sacc=Q0[0]+Q0[1]; _Pragma("unroll") for(int r=2;r<16;++r)sacc+=Q0[r]; _Pragma("unroll") for(int r=0;r<16;++r)sacc+=Q1[r]; l_reg+=sacc; \
    pw0=(u32x4){PKW(Q0,0),PKW(Q0,2),PKW(Q0,4),PKW(Q0,6)};pw1=(u32x4){PKW(Q0,8),PKW(Q0,10),PKW(Q0,12),PKW(Q0,14)};pw2=(u32x4){PKW(Q1,0),PKW(Q1,2),PKW(Q1,4),PKW(Q1,6)};pw3=(u32x4){PKW(Q1,8),PKW(Q1,10),PKW(Q1,12),PKW(Q1,14)}; \
    SBAR(); pv(o,vb0+sl_cur,PAF(0),PAF(1),PAF(2),PAF(3)); }while(0)
  if(t+1<NT){
    STEP(pB0,pB1,pA0,pA1,t,(t+3<NT),(t+1<NT),(t+1<NT));       ENDW(t);   RESC(); ROT();
    pA0=pB0; pA1=pB1;
  }
  STEP(pB0,pB1,pA0,pA1,NT-1,false,false,false); RESC();
  DRAIN(pB0,pB1);
  #undef DRAIN
  asm volatile("s_waitcnt lgkmcnt(0)\n\ts_barrier":::"memory");
  if(has_next){
    const bf16*Khn=Pb+KCOL+udn.kvh*D,*Vhn=Pb+VCOL+udn.kvh*D;
    const bf16*ksn=Khn+(long)lane*PITCH+wid*8, *vsn=Vhn+(long)(16*(wid&3)+(lane>>2))*PITCH+(wid>>2)*32+(lane&3)*8;
    const long r0=(long)udn.ctxrow0;
    glds16(ksn+r0*PITCH,(unsigned)__builtin_amdgcn_readfirstlane(kdst));
    glds16(vsn+r0*PITCH,(unsigned)__builtin_amdgcn_readfirstlane(vdst));
    glds16(ksn+(r0+64)*PITCH,(unsigned)__builtin_amdgcn_readfirstlane(kdst+SLOTB));
    glds16(ksn+(r0+128)*PITCH,(unsigned)__builtin_amdgcn_readfirstlane(kdst+2*SLOTB));
    const bf16*Qn=Pb+(long)(udn.qrow0+(wid&1)*QBLK)*PITCH+QCOL+(udn.hq0+(wid>>1))*D;
    #pragma unroll
    for(int d0=0;d0<4;++d0)qr[d0]=*reinterpret_cast<const bf16x8*>(&Qn[(long)r32*PITCH+d0*16+hi*8]);
  }
  #undef PKW
  #undef PAF
  #undef VFR
  #undef PIN
  #undef MX3
  #undef GAPA
  #undef GAPB
  #undef EX
  #undef VRD
  #undef KRD
  #undef STEP
  #undef ENDW
  {auto rr=__builtin_amdgcn_permlane32_swap(__float_as_uint(l_reg),__float_as_uint(l_reg),false,false);l_reg=__uint_as_float(rr[0])+__uint_as_float(rr[1]);}
  l_reg+=__builtin_amdgcn_exp2f(sink_l2[hq]-mhat);
  if(hi==0)wsf[32+r32]=l_reg;asm volatile("s_waitcnt lgkmcnt(0)":::"memory");
  float rli[16];
  #pragma unroll
  for(int r=0;r<16;++r)rli[r]=__builtin_amdgcn_rcpf(wsf[32+crow(r,hi)]);
  { bf16*stg=(bf16*)(shm+LDS_OST)+wid*2048;
    #pragma unroll
    for(int r=0;r<16;++r){const int orow=crow(r,hi);
      #pragma unroll
      for(int d0=0;d0<2;++d0)stg[orow*64+d0*32+r32]=__float2bfloat16(o[d0][r]*rli[r]);}
    asm volatile("s_waitcnt lgkmcnt(0)":::"memory");
    const long orow0=(long)(ud.qrow0+(wid&1)*QBLK);
    #pragma unroll
    for(int i=0;i<4;++i){const int row=i*8+(lane>>3),ch=lane&7; const u32x4 v=*(const u32x4*)(stg+row*64+ch*8);
      *(u32x4*)(MG+(orow0+row)*MGP+hq*D+ch*8)=v;
      float q=0.f;
      #pragma unroll
      for(int e=0;e<4;++e){const float x0=__uint_as_float(v[e]<<16),x1=__uint_as_float(v[e]&0xffff0000u);q+=x0*x0+x1*x1;}
      q+=__shfl_xor(q,1);q+=__shfl_xor(q,2);q+=__shfl_xor(q,4);
      if(ch==0)SSQ[(orow0+row)*16+hq]=q;} }
  if(has_next) asm volatile("":"+v"(qr[0]),"+v"(qr[1]),"+v"(qr[2]),"+v"(qr[3]));
  #undef DMA_K
  #undef JBF
  #undef KROW
  #undef DMA_V
  #undef CMASK
  #undef START
  #undef RESC
  #undef ROT
}
constexpr int ATTN_LDS_BYTES=LDS_BYTES;
#undef SBAR
#undef WAIT_BAR
}


constexpr int NWAVES = 8;
constexpr int DM = 2048, NBATCH = 2, SEQ = 8192, DEPTH = 4, LCTX = 256;
constexpr int MLAT = NBATCH * SEQ, MCTX = NBATCH * LCTX, MROWS = MLAT + MCTX;
constexpr int NIN = 4608, PP = 3584, FF = 8192, NMODV = 6 * DM;
constexpr float EPS = 1e-6f;
constexpr float QSCALE = 0.125f * 1.4426950408889634f;
constexpr float LOG2E = 1.4426950408889634f;
constexpr size_t MiB = 1u << 20;
constexpr size_t WS_CTL = 0, CTL_ZERO_BYTES = 1 * MiB;
constexpr size_t WS_MOD = 1 * MiB;
constexpr size_t WS_ROPE = 2 * MiB;
constexpr size_t WS_SSQ = 3 * MiB;
constexpr size_t WS_SSQX = 5 * MiB;
constexpr size_t WS_GS = 7 * MiB;
constexpr size_t WS_BIAS = 7 * MiB + 320 * 1024;
constexpr int BIAS_PER_LAYER = 3 * 4608 + 3 * 8192;
constexpr int GS_STAGES = DEPTH * 2 + 1, GS_INV_OFF = GS_STAGES * 2 * 2048;
constexpr size_t WS_WIN = 8 * MiB;
constexpr size_t WS_WOUT = 80 * MiB;
constexpr size_t WS_W1 = 112 * MiB;
constexpr size_t WS_W2 = 240 * MiB;
constexpr size_t WS_X = 368 * MiB;
constexpr size_t WS_H = 500 * MiB;
constexpr size_t WS_P = 566 * MiB;
constexpr size_t WS_MG = 715 * MiB;
constexpr size_t WS_U = 781 * MiB;
constexpr size_t WS_SL1 = 1045 * MiB;
constexpr size_t WS_SL2 = 1077 * MiB;
constexpr size_t WS_END = 1141 * MiB;
constexpr int KS_OUT = 4, KS_MLP2 = 4;
static_assert(WS_MOD + (size_t)DEPTH * 3 * NMODV * 4 <= WS_ROPE && WS_SSQ + (size_t)MROWS * 16 * 4 <= WS_SSQX && WS_SSQX + (size_t)MLAT * 32 * 4 <= WS_GS && WS_GS + (size_t)2 * (DEPTH * 2 + 1) * 2 * DM * 4 <= WS_BIAS && WS_BIAS + (size_t)DEPTH * BIAS_PER_LAYER * 4 <= WS_WIN, "ws map a");
static_assert(WS_WIN + (size_t)DEPTH * NIN * DM * 2 <= WS_WOUT && WS_WOUT + (size_t)DEPTH * DM * DM * 2 <= WS_W1 && WS_W1 + (size_t)DEPTH * FF * DM * 2 <= WS_W2 && WS_W2 + (size_t)DEPTH * FF * DM * 2 <= WS_X, "ws map b");
static_assert(WS_X + (size_t)MROWS * DM * 4 <= WS_H && WS_H + (size_t)MROWS * DM * 2 <= WS_P && WS_P + (size_t)MROWS * NIN * 2 <= WS_MG && WS_MG + (size_t)MROWS * DM * 2 <= WS_U && WS_U + (size_t)MROWS * FF * 2 <= WS_SL1 && WS_SL1 + (size_t)KS_OUT * MCTX * DM * 4 <= WS_SL2 && WS_SL2 + (size_t)KS_MLP2 * MCTX * DM * 4 <= WS_END, "ws map c");
constexpr int CW_CMB = 32768;
constexpr int CW_BAR = 4096;
constexpr int RING_OFF = 0, RING_BYTES = 131072;
constexpr int LDSCTL_OFF = RING_BYTES, MISC_OFF = LDSCTL_OFF + 320;
constexpr int TAB_OFF = RING_BYTES + 1024;
constexpr int LDS_BYTES = 147456;
static_assert(MISC_OFF + 128 <= TAB_OFF && TAB_OFF + 2048 <= LDS_BYTES, "LDS map");

#define GAS __attribute__((address_space(1)))
#define LAS __attribute__((address_space(3)))
typedef unsigned short bf16;
typedef unsigned v4u __attribute__((ext_vector_type(4)));
typedef unsigned v2u __attribute__((ext_vector_type(2)));
typedef float f32x4 __attribute__((ext_vector_type(4)));
typedef GAS unsigned gu32;
#define RLX_AGENT __ATOMIC_RELAXED, __HIP_MEMORY_SCOPE_AGENT
#define LDS_WAIT() asm volatile("s_waitcnt lgkmcnt(0)" ::: "memory")
#define VM_WAIT() asm volatile("s_waitcnt vmcnt(0)" ::: "memory")
__device__ __forceinline__ unsigned f2bf(float f) { unsigned u = __builtin_bit_cast(unsigned, f); return (u + 0x7fffu + ((u >> 16) & 1u)) >> 16; }
__device__ __forceinline__ unsigned pk2(float lo, float hi) { return f2bf(lo) | (f2bf(hi) << 16); }
__device__ __forceinline__ float bflo(unsigned w) { return __uint_as_float(w << 16); }
__device__ __forceinline__ float bfhi(unsigned w) { return __uint_as_float(w & 0xffff0000u); }

#define XB_TMO      128
#define XB_XCNT(j)  (256  + 64 * (j))
#define XB_XSUB(j)  (1280 + 64 * (j))
#define XB_XGEN(j)  (2304 + 64 * (j))
#define XB_TOP      3328
#define XB_TOPGEN   3392
#define XCD_BAR_WORDS 3456
#define XB_SPIN_CAP (1u << 18)

__device__ __forceinline__ unsigned xb_ld(unsigned* p)              { return __hip_atomic_load(p, __ATOMIC_RELAXED, __HIP_MEMORY_SCOPE_AGENT); }
__device__ __forceinline__ unsigned xb_add(unsigned* p, unsigned v) { return __hip_atomic_fetch_add(p, v, __ATOMIC_RELAXED, __HIP_MEMORY_SCOPE_AGENT); }
__device__ __forceinline__ unsigned xb_xcc_id() { return (unsigned)__builtin_amdgcn_s_getreg((3 << 11) | 20) & 0xFu; }
#define XB_SPIN(cond, bar) do { unsigned _sp = 0; while (cond) { __builtin_amdgcn_s_sleep(1); \
    if ((++_sp & 255u) == 0u) { if (xb_ld(&(bar)[XB_TMO])) break; if (_sp > XB_SPIN_CAP) { atomicAdd(&(bar)[XB_TMO], 1u); break; } } } } while (0)

struct XcdBarrier {
    unsigned* bar; unsigned x;
    volatile LAS unsigned* st;
};

__device__ __forceinline__ XcdBarrier xcd_barrier_post(unsigned* bar, volatile LAS unsigned* st) {
    XcdBarrier b; b.bar = bar; b.x = xb_xcc_id(); b.st = st;
    if (threadIdx.x == 0) (void)xb_add(&bar[XB_XCNT(b.x)], 1u);
    return b;
}
__device__ __forceinline__ void xcd_barrier_complete(unsigned* bar, unsigned x, unsigned& nloc, unsigned& nx) {
    const unsigned G = gridDim.x * gridDim.y * gridDim.z;
    unsigned sum, cnt, mine, sp = 0u;
    for (;;) {
        sum = 0u; cnt = 0u; mine = 0u;
#pragma unroll
        for (unsigned j = 0; j < 16; ++j) { const unsigned c = xb_ld(&bar[XB_XCNT(j)]); sum += c; cnt += (c > 0u) ? 1u : 0u; mine = (j == x) ? c : mine; }
        if (sum == G) break;
        __builtin_amdgcn_s_sleep(1);
        if ((++sp & 255u) == 0u) { if (xb_ld(&bar[XB_TMO])) break; if (sp > XB_SPIN_CAP) { atomicAdd(&bar[XB_TMO], 1u); break; } }
    }
    nloc = mine > 0u ? mine : 1u; nx = cnt > 0u ? cnt : 1u;
}

__device__ __forceinline__ void xcd_barrier(const XcdBarrier& b) {
    asm volatile("s_waitcnt vmcnt(0)" ::: "memory");
    __syncthreads();
    if (threadIdx.x == 0) {
        unsigned* bar = b.bar;
        __builtin_amdgcn_s_waitcnt(0);
        unsigned nloc = b.st[0], nx = b.st[1];
        if (nloc == 0u) { xcd_barrier_complete(bar, b.x, nloc, nx); b.st[0] = nloc; b.st[1] = nx; }
        const unsigned old = xb_add(&bar[XB_XSUB(b.x)], 1u);
        const unsigned gen = old / nloc;
        if (old + 1u == (gen + 1u) * nloc) {
            __builtin_amdgcn_fence(__ATOMIC_RELEASE, "agent");
            asm volatile("s_waitcnt vmcnt(0)" ::: "memory");
            const unsigned og = xb_add(&bar[XB_TOP], 1u);
            const unsigned tg = og / nx;
            if (og + 1u == (tg + 1u) * nx) xb_add(&bar[XB_TOPGEN], 1u);
            else XB_SPIN(xb_ld(&bar[XB_TOPGEN]) == tg, bar);
            __builtin_amdgcn_fence(__ATOMIC_ACQUIRE, "agent");
            xb_add(&bar[XB_XGEN(b.x)], 1u);
            asm volatile("s_waitcnt vmcnt(0)" ::: "memory");
        } else {
            XB_SPIN(xb_ld(&bar[XB_XGEN(b.x)]) == gen, bar);
            __builtin_amdgcn_fence(__ATOMIC_ACQUIRE, "agent");
            asm volatile("s_waitcnt vmcnt(0)" ::: "memory");
        }
    }
    __syncthreads();
}
struct Frame {
    LAS unsigned char* lds;
    volatile LAS unsigned* MISC;
    gu32* ctl;
    int tid, lane, wave;
    int vcu, G, bx;
    const float *x, *c, *ctx, *c_ctx, *w_ada, *b_ada, *g_norm1, *g_norm2, *w_in, *conv_w, *conv_b, *sink, *g_out_conv, *g_out_attn, *w_out, *w_mlp1, *w_mlp2, *g_final;
    float* out;
    float *MOD, *ROPE, *SSQ, *X, *SL1, *SL2, *SSQX, *GS, *BIAS;
    bf16 *WIN, *WOUT, *W1, *W2, *H, *P, *MG, *U;
};

__device__ __forceinline__ float wave_sum(float v) {
#pragma unroll
    for (int o = 1; o < 64; o <<= 1) v += __shfl_xor(v, o);
    return v;
}

__device__ __forceinline__ void p0_transpose_item(const float* W, int K, int N, bf16* WT, LAS float* scr, int item, int lane, bool permqk, const float* kscale = nullptr) {
    const int nblk = N / 32, kb = item / nblk, nb = item % nblk, k0 = 64 * kb, n0 = 32 * nb;
    const int r8 = lane >> 3, c4 = (lane & 7) * 4;
    const bool ilv = permqk && n0 >= 1024 && n0 < 3072, rot = permqk && n0 >= 3072 && n0 < 4352;
    const int g0 = (n0 - 1024) & 255, cb = ((n0 - 1024) >> 8) * 128 + ((g0 >> 5) & 3) * 32 + (g0 >> 7) * 4;
    const int srcc = ilv ? ((c4 < 16 ? 1024 : 2048) + cb + 8 * ((c4 & 15) >> 2)) : n0 + c4;
    f32x4 wv[8];
#pragma unroll
    for (int it = 0; it < 8; ++it) wv[it] = *(const f32x4*)(W + (size_t)(k0 + 8 * it + r8) * N + srcc);
#pragma unroll
    for (int it = 0; it < 8; ++it) { const int kk = 8 * it + r8; f32x4 v = wv[it]; if (kscale && k0 >= K / 2) v *= kscale[k0 + kk - K / 2];
#pragma unroll
        for (int e = 0; e < 4; ++e) { const int lc = c4 + e; const int pc = (ilv || rot) ? (2 * (lc & 15) + (lc >> 4)) : lc; scr[kk * 33 + pc] = v[e]; } }
    const int k0d = kscale ? ((k0 + K / 2) & (K - 1)) : k0;
    LDS_WAIT(); asm volatile("" ::: "memory");
    const int c = lane & 7;
#pragma unroll
    for (int j = 0; j < 4; ++j) { const int n = (lane >> 3) + 8 * j; const LAS float* s = scr + (8 * c) * 33 + n;
        v4u o; o.x = pk2(s[0 * 33], s[1 * 33]); o.y = pk2(s[2 * 33], s[3 * 33]); o.z = pk2(s[4 * 33], s[5 * 33]); o.w = pk2(s[6 * 33], s[7 * 33]);
        *(GAS v4u*)(WT + (size_t)(n0 + n) * K + k0d + 8 * c) = o; }
    LDS_WAIT(); asm volatile("" ::: "memory");
}

constexpr int P0_SCR_BYTES = 64 * 33 * 4;
constexpr int P0_SC_OFF = 8 * P0_SCR_BYTES;
constexpr int P0_PART_OFF = P0_SC_OFF + 3 * DM * 4;
static_assert(P0_PART_OFF + 8 * 3 * 64 * 16 <= RING_BYTES, "prologue LDS");

__device__ __forceinline__ void p0_prologue(Frame& F) {
    {
        LAS float* sc = (LAS float*)(F.lds + P0_SC_OFF);
        for (int i = F.tid; i < 3 * DM; i += NWAVES * 64) { const int v = i / DM, k = i % DM; const float cv = v < 2 ? F.c[v * DM + k] : F.c_ctx[k]; sc[i] = cv / (1.f + __expf(-cv)); }
        __syncthreads();
        LAS f32x4* part = (LAS f32x4*)(F.lds + P0_PART_OFF);
        for (int task = blockIdx.x; task < DEPTH * 48; task += F.G) {
            const int l = task / 48, cg = task % 48;
            const float* W = F.w_ada + (size_t)l * DM * NMODV + cg * 256 + 4 * F.lane;
            const int k0 = F.wave * 256;
            f32x4 a0 = {0.f, 0.f, 0.f, 0.f}, a1 = a0, a2 = a0;
            for (int k = k0; k < k0 + 256; k += 8) {
                f32x4 w[8];
#pragma unroll
                for (int u = 0; u < 8; ++u) w[u] = *(const f32x4*)(W + (size_t)(k + u) * NMODV);
#pragma unroll
                for (int u = 0; u < 8; ++u) { const float s0 = sc[k + u], s1 = sc[DM + k + u], s2 = sc[2 * DM + k + u]; a0 += w[u] * s0; a1 += w[u] * s1; a2 += w[u] * s2; }
            }
            part[(F.wave * 3 + 0) * 64 + F.lane] = a0; part[(F.wave * 3 + 1) * 64 + F.lane] = a1; part[(F.wave * 3 + 2) * 64 + F.lane] = a2;
            __syncthreads();
            if (F.tid < 192) { const int v = F.tid >> 6, ln = F.tid & 63; f32x4 s = part[v * 64 + ln];
#pragma unroll
                for (int w = 1; w < 8; ++w) s += part[(w * 3 + v) * 64 + ln];
                s += *(const f32x4*)(F.b_ada + (size_t)l * NMODV + cg * 256 + 4 * ln);
                *(f32x4*)(F.MOD + (size_t)(l * 3 + v) * NMODV + cg * 256 + 4 * ln) = s; }
            __syncthreads();
        }
    }
    const int gw = F.vcu * NWAVES + F.wave, NGW = F.G * NWAVES;
    {
        const int gt = gw * 64 + F.lane;
        if (gt < 128 * 16) { const int pos = gt >> 4, j = gt & 15;
            const float inv = exp2f(-(float)j * (13.287712379549449f / 16.0f));
            const float angf = (float)pos * inv;
            double a = (double)angf; const double twopi = 6.283185307179586476925; const double kq = __builtin_rint(a / twopi); a -= kq * twopi;
            const double a2 = a * a; double sn = 0.0, cs = 0.0, ts = a, tc = 1.0;
            for (int n = 0; n < 16; ++n) { sn += ts; cs += tc; ts *= -a2 / (double)((2 * n + 2) * (2 * n + 3)); tc *= -a2 / (double)((2 * n + 1) * (2 * n + 2)); }
            F.ROPE[gt * 2] = (float)cs; F.ROPE[gt * 2 + 1] = (float)sn; }
    }
    {
        LAS float* scr = (LAS float*)(F.lds + F.wave * P0_SCR_BYTES);
        constexpr int I_IN = (DM / 64) * (NIN / 32), I_OUT = (DM / 64) * (DM / 32), I_1 = (DM / 64) * (FF / 32), I_2 = (FF / 64) * (DM / 32);
        constexpr int PER_A = I_IN + I_1, TOT = DEPTH * PER_A;
        for (int it = gw; it < TOT; it += NGW) {
            if (it < DEPTH * PER_A) { const int l = it / PER_A; int r = it % PER_A;
                if (r < I_IN) { p0_transpose_item(F.w_in + (size_t)l * DM * NIN, DM, NIN, F.WIN + (size_t)l * NIN * DM, scr, r, F.lane, true); continue; } r -= I_IN;
                p0_transpose_item(F.w_mlp1 + (size_t)l * DM * FF, DM, FF, F.W1 + (size_t)l * FF * DM, scr, r, F.lane, false); continue; }
        }
    }
}
__device__ __forceinline__ void deferred_convert(Frame& F, int l, int first_idle, int nidle) {
    LAS float* scr = (LAS float*)(F.lds + F.wave * P0_SCR_BYTES);
    constexpr int I_OUT = (DM / 64) * (DM / 32), I_2 = (FF / 64) * (DM / 32);
    const int w = (F.bx - first_idle) * NWAVES + F.wave, nw = nidle * NWAVES;
    for (int it = w; it < I_OUT + I_2; it += nw) {
        if (it < I_OUT) p0_transpose_item(F.w_out + (size_t)l * DM * DM, DM, DM, F.WOUT + (size_t)l * DM * DM, scr, it, F.lane, false, F.g_out_attn + (size_t)l * 1024);
        else p0_transpose_item(F.w_mlp2 + (size_t)l * FF * DM, FF, DM, F.W2 + (size_t)l * DM * FF, scr, it - I_OUT, F.lane, false);
    }
}

__device__ __forceinline__ void norm_row(Frame& F, int row, const f32x4* xr, const float* g, const float* modl  , int shift_chunk, const float* slab, int nslab) {
    const int mi = row < SEQ ? 0 : (row < MLAT ? 1 : 2);
    f32x4 v[8]; float ss = 0.f;
#pragma unroll
    for (int j = 0; j < 8; ++j) v[j] = xr[64 * j];
    if (row >= MLAT && nslab > 0) {
        for (int kc = 0; kc < nslab; ++kc) { const f32x4* sr = (const f32x4*)(slab + ((size_t)kc * MCTX + (row - MLAT)) * DM) + F.lane;
#pragma unroll
            for (int j = 0; j < 8; ++j) v[j] += sr[64 * j]; }
        f32x4* xw = (f32x4*)(F.X + (size_t)row * DM) + F.lane;
#pragma unroll
        for (int j = 0; j < 8; ++j) xw[64 * j] = v[j];
    }
#pragma unroll
    for (int j = 0; j < 8; ++j) ss += (v[j].x * v[j].x + v[j].y * v[j].y) + (v[j].z * v[j].z + v[j].w * v[j].w);
    const float rstd = 1.0f / sqrtf(wave_sum(ss) * (1.0f / DM) + EPS);
    const f32x4* g4 = (const f32x4*)g + F.lane;
    const f32x4* sh4 = (const f32x4*)(modl + (size_t)mi * NMODV + shift_chunk * DM) + F.lane;
    const f32x4* sc4 = (const f32x4*)(modl + (size_t)mi * NMODV + (shift_chunk + 1) * DM) + F.lane;
    v2u* o8 = (v2u*)(F.H + (size_t)row * DM) + F.lane;
#pragma unroll
    for (int j = 0; j < 8; ++j) { const f32x4 gg = g4[64 * j], sh = sh4[64 * j], sc = sc4[64 * j];
        const f32x4 y = (v[j] * rstd) * gg * (sc + 1.0f) + sh;
        v2u w; w.x = pk2(y.x, y.y); w.y = pk2(y.z, y.w); o8[64 * j] = w; }
}
__device__ __forceinline__ void p0b_phase(Frame& F) {
    const int gw = F.vcu * NWAVES + F.wave, NGW = F.G * NWAVES;
    {
        const int gid = blockIdx.x * (NWAVES * 64) + F.tid;
        if (gid < GS_STAGES * 2 * DM) { const int t = gid >> 12, b = (gid >> 11) & 1, c = gid & (DM - 1); float gsv = 1.0f;
            if (t < 2 * DEPTH) { const int l = t >> 1, j = t & 1;
                const float g = (j ? F.g_norm2 : F.g_norm1)[l * DM + c]; const float sc = F.MOD[(size_t)(l * 3 + b) * NMODV + (j ? 4 : 1) * DM + c];
                gsv = g * (1.0f + sc); if (!(fabsf(gsv) >= 1e-20f)) gsv = (gsv < 0.f) ? -1e-20f : 1e-20f; }
            F.GS[gid] = gsv; F.GS[GS_INV_OFF + gid] = 1.0f / gsv; }
    }
    {
        constexpr int RPL = NIN + FF;
        static_assert((DEPTH * RPL) % (256 * NWAVES) == 0 && RPL % ((DEPTH * RPL) / (256 * NWAVES)) == 0, "bias rows per wave");
        const int per = (DEPTH * RPL) / NGW;
        const int Rb = gw * per, l = Rb / RPL, rb = Rb % RPL;
        const int cnt0 = rb >= NIN ? 0 : ((rb + per <= NIN) ? per : NIN - rb);
        for (int seg = 0; seg < 2; ++seg) {
            const int cnt = seg ? per - cnt0 : cnt0; if (cnt == 0) continue;
            const int mat = seg, n0 = seg ? rb + cnt0 - NIN : rb;
            float sh0[32], sh1[32];
            { const float* m0 = F.MOD + (size_t)(l * 3 + 0) * NMODV + (mat ? 3 : 0) * DM + 8 * F.lane; const float* m1 = m0 + NMODV;
#pragma unroll
                for (int j = 0; j < 4; ++j)
#pragma unroll
                    for (int h4 = 0; h4 < 2; ++h4) { const f32x4 a = *(const f32x4*)(m0 + 512 * j + 4 * h4), b = *(const f32x4*)(m1 + 512 * j + 4 * h4);
#pragma unroll
                        for (int e = 0; e < 4; ++e) { sh0[j * 8 + h4 * 4 + e] = a[e]; sh1[j * 8 + h4 * 4 + e] = b[e]; } } }
            const bf16* wbase = (mat ? F.W1 + (size_t)l * FF * DM : F.WIN + (size_t)l * NIN * DM) + 8 * F.lane;
            float* bo = F.BIAS + (size_t)l * BIAS_PER_LAYER + (mat ? 3 * NIN : 0); const int N = mat ? FF : NIN;
#pragma unroll 1
            for (int i0 = 0; i0 < cnt; i0 += 5) {
                v4u wv[5][4];
#pragma unroll
                for (int q = 0; q < 5; ++q) if (i0 + q < cnt) {
#pragma unroll
                    for (int j = 0; j < 4; ++j) wv[q][j] = *(const v4u*)(wbase + (size_t)(n0 + i0 + q) * DM + 512 * j); }
#pragma unroll
                for (int q = 0; q < 5; ++q) if (i0 + q < cnt) { float s0 = 0.f, s1 = 0.f;
#pragma unroll
                    for (int j = 0; j < 4; ++j)
#pragma unroll
                        for (int e = 0; e < 4; ++e) { const float lo = bflo(wv[q][j][e]), hi = bfhi(wv[q][j][e]);
                            s0 += lo * sh0[j * 8 + 2 * e] + hi * sh0[j * 8 + 2 * e + 1]; s1 += lo * sh1[j * 8 + 2 * e] + hi * sh1[j * 8 + 2 * e + 1]; }
                    s0 = wave_sum(s0); s1 = wave_sum(s1);
                    if (F.lane == 0) { const int n = n0 + i0 + q; bo[n] = s0; bo[N + n] = s1; bo[2 * N + n] = 0.f; } }
            }
        }
    }
    for (int row0 = gw; row0 < MLAT; row0 += 2 * NGW) {
        f32x4 v[2][8];
#pragma unroll
        for (int q = 0; q < 2; ++q) { const f32x4* xr = (const f32x4*)(F.x + (size_t)(row0 + q * NGW) * DM) + F.lane;
#pragma unroll
            for (int j = 0; j < 8; ++j) v[q][j] = xr[64 * j]; }
#pragma unroll
        for (int q = 0; q < 2; ++q) { const int row = row0 + q * NGW; const int b = row >= SEQ ? 1 : 0; float ss = 0.f;
#pragma unroll
            for (int j = 0; j < 8; ++j) ss += (v[q][j].x * v[q][j].x + v[q][j].y * v[q][j].y) + (v[q][j].z * v[q][j].z + v[q][j].w * v[q][j].w);
            ss = wave_sum(ss);
            const f32x4* g4 = (const f32x4*)F.g_norm1 + F.lane; const f32x4* sc4 = (const f32x4*)(F.MOD + (size_t)b * NMODV + DM) + F.lane;
            v2u* o8 = (v2u*)(F.H + (size_t)row * DM) + F.lane;
#pragma unroll
            for (int j = 0; j < 8; ++j) { f32x4 gq = g4[64 * j] * (sc4[64 * j] + 1.0f);
#pragma unroll
                for (int e = 0; e < 4; ++e) if (!(fabsf(gq[e]) >= 1e-20f)) gq[e] = (gq[e] < 0.f) ? -1e-20f : 1e-20f;
                const f32x4 y = v[q][j] * gq; v2u w; w.x = pk2(y.x, y.y); w.y = pk2(y.z, y.w); o8[64 * j] = w; }
            if (F.lane < 32) F.SSQX[(size_t)row * 32 + F.lane] = F.lane == 0 ? ss : 0.f; }
    }
    for (int row = MLAT + gw; row < MROWS; row += NGW) norm_row(F, row, (const f32x4*)(F.ctx + (size_t)(row - MLAT) * DM) + F.lane, F.g_norm1, F.MOD, 0, nullptr, 0);
}
__device__ __forceinline__ void ctx_combine(Frame& F, int nsub, gu32* cnt, const float* xsrc  , const float* g, const float* modl, int shift_chunk, const float* slab, int nslab) {
    if ((int)blockIdx.x >= nsub) return;
    VM_WAIT(); __syncthreads();
    if (F.tid == 0) {
        __builtin_amdgcn_fence(__ATOMIC_RELEASE, "agent"); VM_WAIT();
        __hip_atomic_fetch_add(cnt, 1u, RLX_AGENT);
        unsigned sp = 0;
        while (__hip_atomic_load(cnt, RLX_AGENT) < (unsigned)nsub) { __builtin_amdgcn_s_sleep(2); if (++sp > (1u << 20)) { __hip_atomic_store(F.ctl + 1, 0xC0DEu, RLX_AGENT); break; } }
        __builtin_amdgcn_fence(__ATOMIC_ACQUIRE, "agent"); VM_WAIT();
    }
    __syncthreads();
    const int rpc = MCTX / nsub;
    for (int r = F.wave; r < rpc; r += NWAVES) { const int row = MLAT + (int)blockIdx.x * rpc + r;
        norm_row(F, row, (const f32x4*)(xsrc + (size_t)(row - MLAT) * DM) + F.lane, g, modl, shift_chunk, slab, nslab); }
}
__device__ __forceinline__ void final_norm_phase(Frame& F) {
    const int gw = F.vcu * NWAVES + F.wave, NGW = F.G * NWAVES;
    const f32x4* g4 = (const f32x4*)F.g_final + F.lane;
    for (int row0 = gw; row0 < MLAT; row0 += 4 * NGW) {
        v2u w[4][8];
#pragma unroll
        for (int q = 0; q < 4; ++q) { const v2u* xr = (const v2u*)(F.H + (size_t)(row0 + q * NGW) * DM) + F.lane;
#pragma unroll
            for (int j = 0; j < 8; ++j) w[q][j] = xr[64 * j]; }
#pragma unroll
        for (int q = 0; q < 4; ++q) { f32x4 v[8]; float ss = 0.f;
#pragma unroll
            for (int j = 0; j < 8; ++j) { v[j] = (f32x4){bflo(w[q][j].x), bfhi(w[q][j].x), bflo(w[q][j].y), bfhi(w[q][j].y)}; ss += (v[j].x * v[j].x + v[j].y * v[j].y) + (v[j].z * v[j].z + v[j].w * v[j].w); }
            const float rstd = 1.0f / sqrtf(wave_sum(ss) * (1.0f / DM) + EPS);
            f32x4* o = (f32x4*)(F.out + (size_t)(row0 + q * NGW) * DM) + F.lane;
#pragma unroll
            for (int j = 0; j < 8; ++j) o[64 * j] = (v[j] * rstd) * g4[64 * j]; }
    }
}
__device__ __forceinline__ void conv_phase(Frame& F, int layer, int nrows) {
    const int gw = F.vcu * NWAVES + F.wave, NGW = F.G * NWAVES;
    const float* cw = F.conv_w + (size_t)layer * 3 * 1024; const float* cb = F.conv_b + (size_t)layer * 1024; const float* go = F.g_out_conv + (size_t)layer * 1024;
    float w0[16], w1[16], w2[16], bb[16], gg[16];
#pragma unroll
    for (int hh = 0; hh < 2; ++hh)
#pragma unroll
        for (int q4 = 0; q4 < 2; ++q4) { const int ch = hh * 512 + 8 * F.lane + 4 * q4;
            const f32x4 a0 = *(const f32x4*)(cw + ch), a1 = *(const f32x4*)(cw + 1024 + ch), a2 = *(const f32x4*)(cw + 2048 + ch), a3 = *(const f32x4*)(cb + ch), a4 = *(const f32x4*)(go + ch);
#pragma unroll
            for (int e = 0; e < 4; ++e) { const int k = hh * 8 + q4 * 4 + e; w0[k] = a0[e]; w1[k] = a1[e]; w2[k] = a2[e]; bb[k] = a3[e]; gg[k] = a4[e]; } }
    for (int run = NGW - 1 - gw; run < nrows / 8; run += NGW) {
        const int r0 = run * 8;
        const bool seq_start = (r0 == 0) || (r0 == SEQ) || (r0 == MLAT) || (r0 == MLAT + LCTX);
        const int rend = r0 + 8;
        const bool seq_end = (rend == SEQ) || (rend == MLAT) || (rend == MLAT + LCTX) || (rend == MROWS);
#pragma unroll 1
        for (int h = 0; h < 2; ++h) {
            const int a = r0 + 4 * h;
            v4u ur[6][2], br[4][2];
#pragma unroll
            for (int j = 0; j < 6; ++j) {
                const bool valid = !((j == 0 && h == 0 && seq_start) || (j == 5 && h == 1 && seq_end));
                const bf16* pr_ = F.P + (size_t)(a - 1 + j) * PP + 8 * F.lane + 1024;
#pragma unroll
                for (int hh = 0; hh < 2; ++hh) { if (valid) ur[j][hh] = *(const v4u*)(pr_ + hh * 512); else ur[j][hh] = (v4u){0u, 0u, 0u, 0u}; }
            }
#pragma unroll
            for (int i = 0; i < 4; ++i) { const bf16* pr = F.P + (size_t)(a + i) * PP + 8 * F.lane;
#pragma unroll
                for (int hh = 0; hh < 2; ++hh) br[i][hh] = *(const v4u*)(pr + hh * 512); }
#pragma unroll
            for (int i = 0; i < 4; ++i) {
                const int row = a + i;
                float y[16]; float ss = 0.f;
#pragma unroll
                for (int hh = 0; hh < 2; ++hh) {
#pragma unroll
                    for (int e = 0; e < 8; ++e) {
                        const unsigned wp = ur[i][hh][e >> 1], wc_ = ur[i + 1][hh][e >> 1], wn = ur[i + 2][hh][e >> 1], wb = br[i][hh][e >> 1];
                        const float up = (e & 1) ? bfhi(wp) : bflo(wp), uc = (e & 1) ? bfhi(wc_) : bflo(wc_), un = (e & 1) ? bfhi(wn) : bflo(wn), bg = (e & 1) ? bfhi(wb) : bflo(wb);
                        const int k = hh * 8 + e;
                        const float cv = up * w0[k] + uc * w1[k] + un * w2[k] + bb[k];
                        y[k] = bg * cv; ss += y[k] * y[k];
                    }
                }
                const float rstd = 1.0f / sqrtf(wave_sum(ss) * (1.0f / 1024.0f) + EPS);
                bf16* mo = F.MG + (size_t)row * DM + 1024 + 8 * F.lane;
#pragma unroll
                for (int hh = 0; hh < 2; ++hh) { v4u w;
#pragma unroll
                    for (int e = 0; e < 4; ++e) w[e] = pk2(y[hh * 8 + 2 * e] * rstd * gg[hh * 8 + 2 * e], y[hh * 8 + 2 * e + 1] * rstd * gg[hh * 8 + 2 * e + 1]);
                    *(v4u*)(mo + hh * 512) = w; }
            }
        }
    }
}
__device__ __forceinline__ void attn_rstd_table(Frame& F, int pm, LAS float* tab) {
    const int row = F.tid >> 1, half = F.tid & 1;
    const f32x4* q4 = (const f32x4*)(F.SSQ + (size_t)(pm * 256 + row) * 16 + half * 8);
    const f32x4 a = q4[0], b = q4[1];
    float q = ((a.x + a.y) + (a.z + a.w)) + ((b.x + b.y) + (b.z + b.w));
    q += __shfl_xor(q, 1);
    if (half == 0) tab[row] = 1.0f / sqrtf(q * (1.0f / 1024.0f) + EPS);
}
__device__ __forceinline__ void attention_phase(Frame& F, int layer, bool with_ctx) {
    LAS float* sk = (LAS float*)(F.lds + RING_OFF + attp::LDS_BYTES);
    if (F.tid < 16) sk[F.tid] = F.sink[layer * 16 + F.tid] * LOG2E;
    __syncthreads();
    const int NU = 1024 + (with_ctx ? 32 : 0);
    auto unit_desc = [](int u) { attp::UnitDesc ud;
        if (u < 1024) { const int kvh = u & 3, nb = (u >> 2) & 127, b = u >> 9;
            ud.qrow0 = b * SEQ + nb * 64; ud.hq0 = kvh * 4; ud.kvh = kvh; ud.ctxrow0 = MLAT + b * LCTX; ud.bandrow0 = b * SEQ + nb * 64 - 128;
            ud.jb_lo = nb < 2 ? 2 - nb : 0; ud.jb_hi = nb > 125 ? 130 - nb : 5; }
        else { const int v = u - 1024; const int kvh = v & 3, qb = (v >> 2) & 3, b = v >> 4;
            ud.qrow0 = MLAT + b * LCTX + qb * 64; ud.hq0 = kvh * 4; ud.kvh = kvh; ud.ctxrow0 = MLAT + b * LCTX; ud.bandrow0 = 0; ud.jb_lo = 0; ud.jb_hi = 0; }
        return ud; };
    attp::bf16x8 qr[4]; bool pref = false;
    for (int u = F.vcu; u < NU; u += F.G) {
        const bool has_next = u + F.G < NU;
        const attp::UnitDesc ud = unit_desc(u), udn = unit_desc(has_next ? u + F.G : u);
        attp::attn_unit<8>(ud, udn, has_next, pref, qr, (const attp::bf16*)F.P, (attp::bf16*)F.MG, F.SSQ, sk, (char*)(F.lds + RING_OFF));
        pref = has_next;
    }
}

struct Args { const float* in[18]; float* out; unsigned char* ws; int ph_lo, ph_hi; };
constexpr int PH_PER_LAYER = 7, PH_TOTAL = 2 + DEPTH * PH_PER_LAYER + 1;

typedef __attribute__((address_space(4))) const Args* KArgs;
__device__ __forceinline__ void build_frame(Frame& F, unsigned char* lds) {
    KArgs ap = (KArgs)__builtin_amdgcn_kernarg_segment_ptr(); asm volatile("" : "+s"(ap));
    int tid = threadIdx.x; asm volatile("" : "+v"(tid));
    F.lds = (LAS unsigned char*)lds;
    F.MISC = (volatile LAS unsigned*)(F.lds + MISC_OFF);
    F.tid = tid; F.lane = tid & 63; F.wave = __builtin_amdgcn_readfirstlane(tid >> 6);
    F.G = gridDim.x; { int bx = blockIdx.x; asm volatile("" : "+s"(bx)); F.bx = bx; F.vcu = (bx & 7) * (F.G >> 3) + (bx >> 3); }
    unsigned char* ws = ap->ws;
    F.ctl = (gu32*)(ws + WS_CTL);
    F.x = ap->in[0]; F.c = ap->in[1]; F.ctx = ap->in[2]; F.c_ctx = ap->in[3]; F.w_ada = ap->in[4]; F.b_ada = ap->in[5]; F.g_norm1 = ap->in[6]; F.g_norm2 = ap->in[7];
    F.w_in = ap->in[8]; F.conv_w = ap->in[9]; F.conv_b = ap->in[10]; F.sink = ap->in[11]; F.g_out_conv = ap->in[12]; F.g_out_attn = ap->in[13]; F.w_out = ap->in[14];
    F.w_mlp1 = ap->in[15]; F.w_mlp2 = ap->in[16]; F.g_final = ap->in[17]; F.out = ap->out;
    F.MOD = (float*)(ws + WS_MOD); F.ROPE = (float*)(ws + WS_ROPE); F.SSQ = (float*)(ws + WS_SSQ); F.X = (float*)(ws + WS_X); F.SL1 = (float*)(ws + WS_SL1); F.SL2 = (float*)(ws + WS_SL2); F.SSQX = (float*)(ws + WS_SSQX); F.GS = (float*)(ws + WS_GS); F.BIAS = (float*)(ws + WS_BIAS);
    F.WIN = (bf16*)(ws + WS_WIN); F.WOUT = (bf16*)(ws + WS_WOUT); F.W1 = (bf16*)(ws + WS_W1); F.W2 = (bf16*)(ws + WS_W2);
    F.H = (bf16*)(ws + WS_H); F.P = (bf16*)(ws + WS_P); F.MG = (bf16*)(ws + WS_MG); F.U = (bf16*)(ws + WS_U);
}

__global__ void __launch_bounds__(NWAVES * 64, 2) mk_fwd(Args args) {
    extern __shared__ __attribute__((aligned(16))) unsigned char lds[];
    for (int u = threadIdx.x; u < (LDS_BYTES - LDSCTL_OFF) / 4; u += NWAVES * 64) ((LAS unsigned*)((LAS unsigned char*)lds + LDSCTL_OFF))[u] = 0u;
    __syncthreads();
    XcdBarrier bar = xcd_barrier_post((unsigned*)(args.ws + WS_CTL) + CW_BAR, (volatile LAS unsigned*)((LAS unsigned char*)lds + MISC_OFF) + 8);

    const int lo = args.ph_lo, hi = args.ph_hi;
    int ph = 0;
#define IN_RANGE(k) (lo <= (k) && (k) < hi)
#define SEAM(k) do { if (IN_RANGE(k) && IN_RANGE((k) + 1)) xcd_barrier(bar); } while (0)

    asm volatile("; MARK_P0");
    if (IN_RANGE(ph)) { Frame F; build_frame(F, lds); p0_prologue(F); }
    SEAM(ph); ++ph;
    asm volatile("; MARK_P0B");
    if (IN_RANGE(ph)) { Frame F; build_frame(F, lds); p0b_phase(F); }
    SEAM(ph); ++ph;

    for (int layer = 0; layer < DEPTH; ++layer) {
        const bool last = (layer == DEPTH - 1);
        const int mrows = last ? MLAT : MROWS;
        asm volatile("; MARK_L2");
        if (IN_RANGE(ph)) { Frame F; build_frame(F, lds);
            pg8::Gemm g{F.H, F.WIN + (size_t)layer * NIN * DM, MROWS, NIN, DM, DM}; pg8::StaticOrder S; S.init(MROWS, NIN, F.G, F.bx);
            pg8::EpiIn E{F.P, PP, F.ROPE, QSCALE, MLAT / 256, pg8::NormFold{F.SSQX, F.BIAS + (size_t)layer * BIAS_PER_LAYER, NIN, (LAS float*)(F.lds + TAB_OFF), 1.0f / DM, EPS}};
            pg8::gemm_phase<pg8::EpiIn, pg8::StaticOrder, true, true>(F.lds + RING_OFF, g, S, E);
            constexpr int NU_L2 = (MROWS / 256) * (NIN / 256), FIRST_IDLE = NU_L2 % 256;
            if (F.bx >= FIRST_IDLE) deferred_convert(F, layer, FIRST_IDLE, 256 - FIRST_IDLE);
        }
        SEAM(ph); ++ph;
        asm volatile("; MARK_L3");
        if (IN_RANGE(ph)) { { Frame F; build_frame(F, lds); attention_phase(F, layer, !last); } { Frame F; build_frame(F, lds); conv_phase(F, layer, mrows); } }
        SEAM(ph); ++ph;
        asm volatile("; MARK_L4");
        if (IN_RANGE(ph)) { Frame F; build_frame(F, lds);
            pg8::Gemm g{F.MG, F.WOUT + (size_t)layer * DM * DM, MLAT, DM, DM, DM}; pg8::StaticOrder S; S.init(MLAT, DM, F.G, F.bx);
            LAS float* tab = (LAS float*)(F.lds + TAB_OFF);
            { pg8::Unit u; if (S.next(0, u)) attn_rstd_table(F, u.pm, tab); if (S.next(1, u)) attn_rstd_table(F, u.pm, tab + 256); }
            __syncthreads();
            pg8::EpiRes<true> E{F.H, DM, F.MOD + (size_t)layer * 3 * NMODV + 2 * DM, NMODV, DM / 128  , tab,
                                 F.GS + GS_INV_OFF + (size_t)(2 * layer) * 2 * DM  , F.GS + (size_t)(2 * layer + 1) * 2 * DM  , F.SSQX};
            pg8::gemm_phase<pg8::EpiRes<true>, pg8::StaticOrder, true, true>(F.lds + RING_OFF, g, S, E);
        }
        if (IN_RANGE(ph) && !last) { Frame F; build_frame(F, lds);
            pg8::Gemm g{F.MG, F.WOUT + (size_t)layer * DM * DM, MROWS, DM, DM / KS_OUT, DM}; pg8::SplitOrder S; S.init(MLAT / 256, MCTX / 256, DM / 256, KS_OUT, F.G, F.bx);
            LAS float* tab = (LAS float*)(F.lds + TAB_OFF);
            __syncthreads();
            { pg8::Unit u; if (S.next(0, u)) attn_rstd_table(F, u.pm, tab); }
            __syncthreads();
            pg8::EpiSlab E{F.SL1, DM, F.MOD + (size_t)layer * 3 * NMODV + 2 * NMODV + 2 * DM, MLAT / 256, MCTX, KS_OUT / 2, tab};
            pg8::gemm_phase<pg8::EpiSlab, pg8::SplitOrder, true, true>(F.lds + RING_OFF, g, S, E);
        }
        if (IN_RANGE(ph) && !last) { Frame F; build_frame(F, lds);
            ctx_combine(F, (MCTX / 256) * (DM / 256) * KS_OUT, F.ctl + CW_CMB + 64 * (2 * layer), layer == 0 ? F.ctx : F.X + (size_t)MLAT * DM, F.g_norm2 + (size_t)layer * DM, F.MOD + (size_t)layer * 3 * NMODV, 3, F.SL1, KS_OUT);
        }
        SEAM(ph); ++ph;
        for (int hv = 0; hv < 2; ++hv) {
            const int pm0 = hv * (SEQ / 256);
            const int m6 = SEQ + ((hv == 1 && !last) ? MCTX : 0);
            asm volatile("; MARK_L6");
            if (IN_RANGE(ph)) { Frame F; build_frame(F, lds);
                bf16* Ub = F.U - (size_t)hv * SEQ * FF;
                pg8::Gemm g{F.H, F.W1 + (size_t)layer * FF * DM, m6, FF, DM, DM}; pg8::StaticOrder S; S.init(m6, FF, F.G, F.bx, pm0);
                pg8::EpiSq E{Ub, FF, pg8::NormFold{F.SSQX, F.BIAS + (size_t)layer * BIAS_PER_LAYER + 3 * NIN, FF, (LAS float*)(F.lds + TAB_OFF), 1.0f / DM, EPS}};
                pg8::gemm_phase<pg8::EpiSq, pg8::StaticOrder, true, true>(F.lds + RING_OFF, g, S, E);
            }
            SEAM(ph); ++ph;
            asm volatile("; MARK_L7");
            if (IN_RANGE(ph)) { Frame F; build_frame(F, lds);
                const bf16* Ub = F.U - (size_t)hv * SEQ * FF;
                pg8::Gemm g{Ub, F.W2 + (size_t)layer * DM * FF, SEQ, DM, FF, FF}; pg8::StaticOrder S; S.init(SEQ, DM, F.G, F.bx, pm0);
                pg8::EpiRes<false> E{F.H, DM, F.MOD + (size_t)layer * 3 * NMODV + 5 * DM, NMODV, -1, nullptr,
                                      F.GS + GS_INV_OFF + (size_t)(2 * layer + 1) * 2 * DM  , F.GS + (size_t)(2 * layer + 2) * 2 * DM  , F.SSQX};
                pg8::gemm_phase<pg8::EpiRes<false>, pg8::StaticOrder, true, true>(F.lds + RING_OFF, g, S, E);
            }
            if (IN_RANGE(ph) && !last && hv == 1) { Frame F; build_frame(F, lds);
                const bf16* Ub = F.U - (size_t)SEQ * FF;
                pg8::Gemm g{Ub, F.W2 + (size_t)layer * DM * FF, MROWS, DM, FF / KS_MLP2, FF}; pg8::SplitOrder S; S.init(MLAT / 256, MCTX / 256, DM / 256, KS_MLP2, F.G, F.bx);
                pg8::EpiSlab E{F.SL2, DM, F.MOD + (size_t)layer * 3 * NMODV + 2 * NMODV + 5 * DM, MLAT / 256, MCTX, 0, nullptr};
                pg8::gemm_phase<pg8::EpiSlab, pg8::SplitOrder, true, true>(F.lds + RING_OFF, g, S, E);
            }
            if (IN_RANGE(ph) && !last && hv == 1) { Frame F; build_frame(F, lds);
                ctx_combine(F, (MCTX / 256) * (DM / 256) * KS_MLP2, F.ctl + CW_CMB + 64 * (2 * layer + 1), F.X + (size_t)MLAT * DM, F.g_norm1 + (size_t)(layer + 1) * DM, F.MOD + (size_t)(layer + 1) * 3 * NMODV, 0, F.SL2, KS_MLP2);
            }
            SEAM(ph); ++ph;
        }
    }
    asm volatile("; MARK_FIN");
    if (IN_RANGE(ph)) { Frame F; build_frame(F, lds); final_norm_phase(F); }
#undef IN_RANGE
#undef SEAM
}

#ifndef MK_CUTS
#define MK_CUTS 0
#endif
extern "C" void kernel_launch(void* const* d_in, const int* in_sizes, int n_in, void* d_out, int out_size, void* d_ws, size_t ws_size, hipStream_t stream) {
    static int grid = 0;
    if (grid == 0) {
        if (n_in != 18 || in_sizes[0] != MLAT * DM || out_size != MLAT * DM || ws_size < WS_END) { fprintf(stderr, "kernel_launch: unexpected shapes (n_in %d, in0 %d, out %d, ws %zu); nothing launched\n", n_in, n_in > 0 ? in_sizes[0] : -1, out_size, ws_size); grid = -1; return; }
        int dev = 0, cus = 0, per_cu = 0;
        if (hipGetDevice(&dev) != hipSuccess || hipDeviceGetAttribute(&cus, hipDeviceAttributeMultiprocessorCount, dev) != hipSuccess) { fprintf(stderr, "kernel_launch: device query failed\n"); grid = -1; return; }
        if (hipFuncSetAttribute((const void*)mk_fwd, hipFuncAttributeMaxDynamicSharedMemorySize, LDS_BYTES) != hipSuccess) { fprintf(stderr, "kernel_launch: hipFuncSetAttribute failed\n"); grid = -1; return; }
        if (hipOccupancyMaxActiveBlocksPerMultiprocessor(&per_cu, (const void*)mk_fwd, NWAVES * 64, LDS_BYTES) != hipSuccess || per_cu < 1)
            fprintf(stderr, "kernel_launch: note: occupancy query reports %d workgroups per CU\n", per_cu);
        (void)hipGetLastError();
        grid = cus;
        if (grid != 256) { fprintf(stderr, "kernel_launch: built for a 256-CU device (whole GEMM rounds, one context sub-unit per workgroup); found %d CUs; nothing launched\n", cus); grid = -1; return; }
    }
    if (grid < 0) return;
    if (hipMemsetAsync((char*)d_ws + WS_CTL, 0, CTL_ZERO_BYTES, stream) != hipSuccess) { fprintf(stderr, "kernel_launch: memset failed\n"); return; }
    Args a{};
    for (int i = 0; i < 18; ++i) a.in[i] = (const float*)d_in[i];
    a.out = (float*)d_out; a.ws = (unsigned char*)d_ws;
#if MK_CUTS
    for (int p = 0; p < PH_TOTAL; ++p) { a.ph_lo = p; a.ph_hi = p + 1; hipLaunchKernelGGL(mk_fwd, dim3(grid), dim3(NWAVES * 64), LDS_BYTES, stream, a); }
#else
    a.ph_lo = 0; a.ph_hi = PH_TOTAL;
    hipLaunchKernelGGL(mk_fwd, dim3(grid), dim3(NWAVES * 64), LDS_BYTES, stream, a);
#endif
    const hipError_t le = hipPeekAtLastError();
    if (le != hipSuccess) fprintf(stderr, "kernel_launch: launch failed: %s\n", hipGetErrorName(le));
}
```

```cpp
#include <hip/hip_runtime.h>
#include <cstdio>
#include <cstdint>
#include <cmath>
namespace pg8 {
#define PG8_LAS __attribute__((address_space(3)))
typedef unsigned short bf16_t;
typedef short bf16x8 __attribute__((ext_vector_type(8)));
typedef float f32x4 __attribute__((ext_vector_type(4)));
typedef unsigned u32x4 __attribute__((ext_vector_type(4)));
constexpr int BM = 256, BK = 64, HALF = 128, HTB = HALF * BK * 2  , STAGE_BYTES = 8 * HTB, NXCD = 8, WGM = 4;

__host__ __device__ __forceinline__ int lds_byte(int r, int c) { const int st = (r >> 4) * 2 + (c >> 5), rr = r & 15, cc = c & 31, ob = rr * 64 + cc * 2; return st * 1024 + (ob ^ (((ob >> 9) & 1) << 5)); }
__host__ __device__ __forceinline__ void stage_rc(int b, int& R, int& C) { const int st = b / 1024, sb = b % 1024, swz = sb ^ (((sb >> 9) & 1) << 5); R = (st >> 1) * 16 + swz / 64; C = (st & 1) * 32 + (swz % 64) / 2; }
__host__ __device__ __forceinline__ int perm32(int rho) { const int n = rho >> 4, i = rho & 15; return 8 * (i >> 2) + 4 * n + (i & 3); }

struct Unit { int pm, pn, kc; };
struct Gemm { const bf16_t* A; const bf16_t* Bt; int M, N, K, ldk; };

struct StaticOrder {
    int nM, nN, nwg, G, c, pm0;
    __host__ __device__ void init(int M, int N, int G_, int c_, int pm0_ = 0) { nM = M / BM; nN = N / BM; nwg = nM * nN; G = G_; c = c_; pm0 = pm0_; }
    __host__ __device__ bool next(int i, Unit& u) const {
        const long L = (long)i * G + c; if (L >= nwg) return false;
        int wgid = (int)L; { const int q = nwg / NXCD, r = nwg % NXCD, xcd = wgid % NXCD, off = wgid / NXCD; wgid = (xcd < r ? xcd * (q + 1) : r * (q + 1) + (xcd - r) * q) + off; }
        const int nig = WGM * nN, gid = wgid / nig, fm = gid * WGM, gsz = (nM - fm) < WGM ? (nM - fm) : WGM;
        u.pm = pm0 + fm + ((wgid % nig) % gsz); u.pn = (wgid % nig) / gsz; u.kc = 0; return true;
    }
    __device__ __forceinline__ void a_ready(const Unit&) const {}
    __device__ __forceinline__ void done(const Unit&) const {}
};

__device__ __forceinline__ unsigned cvt_pk_bf16(float lo, float hi) { unsigned r; asm volatile("v_cvt_pk_bf16_f32 %0, %1, %2" : "=v"(r) : "v"(lo), "v"(hi)); return r; }
typedef float f32x2 __attribute__((ext_vector_type(2)));
typedef float f32x2 __attribute__((ext_vector_type(2)));

struct NormFold {
    const float* ssqx; const float* bias; int bstride; PG8_LAS float* tab; float inv_n, eps;
    __device__ __forceinline__ void prep(const Unit& u, int& state, int tid) const {
        if (u.pm == state) return;
        state = u.pm;
        const int row = tid >> 1, half = tid & 1;
        float r = 1.0f;
        if (u.pm < 64) {
            const f32x4* q4 = (const f32x4*)(ssqx + (size_t)(u.pm * BM + row) * 32 + half * 16);
            const f32x4 a = q4[0], b = q4[1], c = q4[2], d = q4[3];
            float q = (((a[0] + a[1]) + (a[2] + a[3])) + ((b[0] + b[1]) + (b[2] + b[3]))) + (((c[0] + c[1]) + (c[2] + c[3])) + ((d[0] + d[1]) + (d[2] + d[3])));
            q += __shfl_xor(q, 1);
            r = 1.0f / sqrtf(q * inv_n + eps);
        }
        if (half == 0) tab[row] = r;
        asm volatile("s_waitcnt lgkmcnt(0)" ::: "memory"); __builtin_amdgcn_s_barrier(); asm volatile("" ::: "memory");
    }
};
struct EpiIn {
    static constexpr bool PERM = true, AFTER_DRAIN = false, HAS_MID = false, HAS_PREP = true;
    bf16_t* O; int ldc; const float* rope; float qscale; int n_lat_tiles;
    NormFold nf;
    __device__ __forceinline__ void prep(const Unit& u, int& state, int tid) const { nf.prep(u, state, tid); }
    __device__ __forceinline__ void operator()(const f32x4 (&acc)[2][2][4][2], const Unit& u, int wr, int wc, int fr, int fq) const {
        const int row0 = u.pm * BM + wr * 64 + fr;
        const int obase = u.pn < 4 ? u.pn * BM : (u.pn < 12 ? 1024 + (u.pn - 4) * HALF : (u.pn - 4) * BM);
        const int col0 = obase + wc * 32 + 8 * fq;
        const bool isq = (u.pn >= 12 && u.pn < 16), isk = (u.pn == 16);
        const float sc = isq ? qscale : 1.f;
        const int mi = u.pm < 32 ? 0 : (u.pm < 64 ? 1 : 2);
        const float* bp = nf.bias + (size_t)mi * nf.bstride + u.pn * BM + wc * 32 + 8 * fq;
        f32x4 bv[2][2];
#pragma unroll
        for (int bj = 0; bj < 2; ++bj) { bv[bj][0] = *(const f32x4*)(bp + bj * HALF); bv[bj][1] = *(const f32x4*)(bp + bj * HALF + 4); }
        if ((isq || isk) && u.pm < n_lat_tiles) {
            const int axis = wc & 1;
            f32x4 ecs[4][2];
#pragma unroll
            for (int k = 0; k < 4; ++k) { const int t = (row0 + (axis ? k * 16 : (k & 1) * HALF)) & 8191; const int pos = axis ? (t & 63) : (t >> 6);
                const f32x4* tp = (const f32x4*)(rope + (size_t)(pos * 16 + 4 * fq) * 2); ecs[k][0] = tp[0]; ecs[k][1] = tp[1]; }
#pragma unroll
            for (int ai = 0; ai < 2; ++ai)
#pragma unroll
                for (int m = 0; m < 4; ++m) {
                    const int r = row0 + ai * HALF + m * 16;
                    const float rs = nf.tab[ai * HALF + wr * 64 + m * 16 + fr];
                    const f32x4 cs0 = axis ? ecs[m][0] : ecs[ai][0], cs1 = axis ? ecs[m][1] : ecs[ai][1];
                    bf16_t* rowp = O + (size_t)r * ldc + col0;
#pragma unroll
                    for (int bj = 0; bj < 2; ++bj) {
                        const f32x4 v0 = acc[ai][bj][m][0] * rs + bv[bj][0], v1 = acc[ai][bj][m][1] * rs + bv[bj][1];
                        const float a0 = (v0[0] * cs0[0] - v0[1] * cs0[1]) * sc, b0 = (v0[1] * cs0[0] + v0[0] * cs0[1]) * sc;
                        const float a1 = (v0[2] * cs0[2] - v0[3] * cs0[3]) * sc, b1 = (v0[3] * cs0[2] + v0[2] * cs0[3]) * sc;
                        const float a2 = (v1[0] * cs1[0] - v1[1] * cs1[1]) * sc, b2 = (v1[1] * cs1[0] + v1[0] * cs1[1]) * sc;
                        const float a3 = (v1[2] * cs1[2] - v1[3] * cs1[3]) * sc, b3 = (v1[3] * cs1[2] + v1[2] * cs1[3]) * sc;
                        u32x4 w; w.x = cvt_pk_bf16(a0, b0); w.y = cvt_pk_bf16(a1, b1); w.z = cvt_pk_bf16(a2, b2); w.w = cvt_pk_bf16(a3, b3);
                        *(u32x4*)(rowp + bj * HALF) = w;
                    }
                }
        } else if (u.pn >= 4 && u.pn < 12) {
#pragma unroll
            for (int ai = 0; ai < 2; ++ai)
#pragma unroll
                for (int m = 0; m < 4; ++m) {
                    bf16_t* rowp = O + (size_t)(row0 + ai * HALF + m * 16) * ldc + obase + wc * 32 + 8 * fq;
                    const float rs = nf.tab[ai * HALF + wr * 64 + m * 16 + fr];
                    const f32x4 v0 = acc[ai][0][m][0] * rs + bv[0][0], v1 = acc[ai][0][m][1] * rs + bv[0][1], v2 = acc[ai][1][m][0] * rs + bv[1][0], v3 = acc[ai][1][m][1] * rs + bv[1][1];
                    u32x4 w; w.x = cvt_pk_bf16(v0[0] * v0[1], v0[2] * v0[3]); w.y = cvt_pk_bf16(v1[0] * v1[1], v1[2] * v1[3]); w.z = cvt_pk_bf16(v2[0] * v2[1], v2[2] * v2[3]); w.w = cvt_pk_bf16(v3[0] * v3[1], v3[2] * v3[3]);
                    *(u32x4*)rowp = w;
                }
        } else {
#pragma unroll
            for (int ai = 0; ai < 2; ++ai)
#pragma unroll
                for (int m = 0; m < 4; ++m) {
                    bf16_t* rowp = O + (size_t)(row0 + ai * HALF + m * 16) * ldc + col0;
                    const float rs = nf.tab[ai * HALF + wr * 64 + m * 16 + fr];
#pragma unroll
                    for (int bj = 0; bj < 2; ++bj) {
                        const f32x4 v0 = (acc[ai][bj][m][0] * rs + bv[bj][0]) * sc, v1 = (acc[ai][bj][m][1] * rs + bv[bj][1]) * sc;
                        u32x4 w; w.x = cvt_pk_bf16(v0[0], v0[1]); w.y = cvt_pk_bf16(v0[2], v0[3]); w.z = cvt_pk_bf16(v1[0], v1[1]); w.w = cvt_pk_bf16(v1[2], v1[3]);
                        *(u32x4*)(rowp + bj * HALF) = w;
                    }
                }
        }
    }
};

struct EpiSq {
    static constexpr bool PERM = true, AFTER_DRAIN = false, HAS_MID = false, HAS_PREP = true;
    bf16_t* O; int ldc;
    NormFold nf;
    __device__ __forceinline__ void prep(const Unit& u, int& state, int tid) const { nf.prep(u, state, tid); }
    __device__ __forceinline__ void operator()(const f32x4 (&acc)[2][2][4][2], const Unit& u, int wr, int wc, int fr, int fq) const {
        const int row0 = u.pm * BM + wr * 64 + fr;
        const int col0 = u.pn * BM + wc * 32 + 8 * fq;
        const int mi = u.pm < 32 ? 0 : (u.pm < 64 ? 1 : 2);
        const float* bp = nf.bias + (size_t)mi * nf.bstride + col0;
        f32x4 bv[2][2];
#pragma unroll
        for (int bj = 0; bj < 2; ++bj) { bv[bj][0] = *(const f32x4*)(bp + bj * HALF); bv[bj][1] = *(const f32x4*)(bp + bj * HALF + 4); }
#pragma unroll
        for (int ai = 0; ai < 2; ++ai)
#pragma unroll
            for (int m = 0; m < 4; ++m) {
                bf16_t* rowp = O + (size_t)(row0 + ai * HALF + m * 16) * ldc + col0;
                const float rs = nf.tab[ai * HALF + wr * 64 + m * 16 + fr];
#pragma unroll
                for (int bj = 0; bj < 2; ++bj) {
                    f32x4 v0 = acc[ai][bj][m][0] * rs + bv[bj][0], v1 = acc[ai][bj][m][1] * rs + bv[bj][1];
                    v0 = __builtin_elementwise_max(v0, (f32x4){0.f, 0.f, 0.f, 0.f}); v1 = __builtin_elementwise_max(v1, (f32x4){0.f, 0.f, 0.f, 0.f});
                    v0 = v0 * v0; v1 = v1 * v1;
                    u32x4 w; w.x = cvt_pk_bf16(v0[0], v0[1]); w.y = cvt_pk_bf16(v0[2], v0[3]); w.z = cvt_pk_bf16(v1[0], v1[1]); w.w = cvt_pk_bf16(v1[2], v1[3]);
                    *(u32x4*)(rowp + bj * HALF) = w;
                }
            }
    }
};

template <bool MID> struct EpiRes {
    static constexpr bool PERM = true, AFTER_DRAIN = false, HAS_MID = MID, HAS_PREP = false;
    bf16_t* XA; int ldc; const float* gate; int gstride;
    int mid_t; const PG8_LAS float* tab;
    const float* ginv_old; const float* gs_new; float* ssqx;
    __device__ __forceinline__ void mid(f32x4 (&acc)[2][2][4][2], int ui, int wr, int fr) const {
#pragma unroll
        for (int ai = 0; ai < 2; ++ai)
#pragma unroll
            for (int m = 0; m < 4; ++m) { const float rs = tab[(ui & 1) * 256 + ai * HALF + wr * 64 + m * 16 + fr];
#pragma unroll
                for (int bj = 0; bj < 2; ++bj)
#pragma unroll
                    for (int n = 0; n < 2; ++n) acc[ai][bj][m][n] *= rs; }
    }
    __device__ __forceinline__ void operator()(const f32x4 (&acc)[2][2][4][2], const Unit& u, int wr, int wc, int fr, int fq) const {
        const int mi = u.pm < 32 ? 0 : 1;
        const float* gv = gate + (size_t)mi * gstride;
        const int row0 = u.pm * BM + wr * 64 + fr;
        const int col0 = u.pn * BM + wc * 32 + 8 * fq;
        f32x4 g[2][2], gi[2][2], gn[2][2];
#pragma unroll
        for (int bj = 0; bj < 2; ++bj)
#pragma unroll
            for (int n = 0; n < 2; ++n) { g[bj][n] = *(const f32x4*)(gv + col0 + bj * HALF + 4 * n);
                gi[bj][n] = *(const f32x4*)(ginv_old + (size_t)mi * 2048 + col0 + bj * HALF + 4 * n);
                gn[bj][n] = *(const f32x4*)(gs_new + (size_t)mi * 2048 + col0 + bj * HALF + 4 * n); }
#pragma unroll
        for (int aq = 0; aq < 4; ++aq) { const int ai = aq >> 1, m0 = (aq & 1) * 2;
            u32x4 xv[2][2];
#pragma unroll
            for (int mm = 0; mm < 2; ++mm)
#pragma unroll
                for (int bj = 0; bj < 2; ++bj) xv[mm][bj] = *(const u32x4*)(XA + (size_t)(row0 + ai * HALF + (m0 + mm) * 16) * ldc + col0 + bj * HALF);
#pragma unroll
            for (int mm = 0; mm < 2; ++mm) { const int m = m0 + mm; const size_t ro = (size_t)(row0 + ai * HALF + m * 16) * ldc + col0; float ss = 0.f;
#pragma unroll
                for (int bj = 0; bj < 2; ++bj) { const u32x4 xw = xv[mm][bj];
                    const f32x4 x0 = {__uint_as_float(xw.x << 16), __uint_as_float(xw.x & 0xffff0000u), __uint_as_float(xw.y << 16), __uint_as_float(xw.y & 0xffff0000u)};
                    const f32x4 x1 = {__uint_as_float(xw.z << 16), __uint_as_float(xw.z & 0xffff0000u), __uint_as_float(xw.w << 16), __uint_as_float(xw.w & 0xffff0000u)};
                    const f32x4 o0 = x0 * gi[bj][0] + g[bj][0] * acc[ai][bj][m][0], o1 = x1 * gi[bj][1] + g[bj][1] * acc[ai][bj][m][1];
                    const f32x4 a0 = o0 * gn[bj][0], a1 = o1 * gn[bj][1];
                    u32x4 wa; wa.x = cvt_pk_bf16(a0[0], a0[1]); wa.y = cvt_pk_bf16(a0[2], a0[3]); wa.z = cvt_pk_bf16(a1[0], a1[1]); wa.w = cvt_pk_bf16(a1[2], a1[3]);
                    *(u32x4*)(XA + ro + bj * HALF) = wa;
                    ss += ((o0[0] * o0[0] + o0[1] * o0[1]) + (o0[2] * o0[2] + o0[3] * o0[3])) + ((o1[0] * o1[0] + o1[1] * o1[1]) + (o1[2] * o1[2] + o1[3] * o1[3])); }
                ss += __shfl_xor(ss, 16); ss += __shfl_xor(ss, 32);
                if (fq == 0) ssqx[(size_t)(row0 + ai * HALF + m * 16) * 32 + u.pn * 4 + wc] = ss; }
            asm volatile("" ::: "memory");
        }
    }
};

struct SplitOrder {
    int nM, nN, ks, G, c, pm0;
    __host__ __device__ void init(int pm0_, int nM_, int nN_, int ks_, int G_, int c_) { pm0 = pm0_; nM = nM_; nN = nN_; ks = ks_; G = G_; c = c_; }
    __host__ __device__ bool next(int i, Unit& u) const {
        const long L = (long)i * G + c; const int nt = nM * nN; if (L >= (long)nt * ks) return false;
        const int t = (int)(L % nt); u.kc = (int)(L / nt); u.pm = pm0 + t % nM; u.pn = t / nM; return true;
    }
    __device__ __forceinline__ void a_ready(const Unit&) const {}
    __device__ __forceinline__ void done(const Unit&) const {}
};
struct EpiSlab {
    static constexpr bool PERM = true, AFTER_DRAIN = false, HAS_MID = false, HAS_PREP = false, HAS_BV = false;
    bf16_t* slab; int ldc; const float* gv; int pm0; int slab_rows;
    int nscaled; const PG8_LAS float* tab;
    __device__ __forceinline__ void operator()(const f32x4 (&acc)[2][2][4][2], const Unit& u, int wr, int wc, int fr, int fq) const {
        const int row0 = (u.pm - pm0) * BM + wr * 64 + fr;
        const int col0 = u.pn * BM + wc * 32 + 8 * fq;
        bf16_t* base = slab + (size_t)u.kc * slab_rows * ldc;
        f32x4 g[2][2];
#pragma unroll
        for (int bj = 0; bj < 2; ++bj)
#pragma unroll
            for (int n = 0; n < 2; ++n) g[bj][n] = *(const f32x4*)(gv + col0 + bj * HALF + 4 * n);
#pragma unroll
        for (int ai = 0; ai < 2; ++ai)
#pragma unroll
            for (int m = 0; m < 4; ++m) { bf16_t* xp = base + (size_t)(row0 + ai * HALF + m * 16) * ldc + col0;
                const float rs = (u.kc < nscaled) ? tab[ai * HALF + wr * 64 + m * 16 + fr] : 1.0f;
#pragma unroll
                for (int bj = 0; bj < 2; ++bj) { const f32x4 v0 = g[bj][0] * acc[ai][bj][m][0] * rs, v1 = g[bj][1] * acc[ai][bj][m][1] * rs;
                    u32x4 w; w.x = cvt_pk_bf16(v0[0], v0[1]); w.y = cvt_pk_bf16(v0[2], v0[3]); w.z = cvt_pk_bf16(v1[0], v1[1]); w.w = cvt_pk_bf16(v1[2], v1[3]);
                    *(u32x4*)(xp + bj * HALF) = w; } }
    }
};

template <class Epi, class Sched, bool ALIGN_EPI = false, bool SP2 = false>
__device__ __forceinline__ void gemm_phase(PG8_LAS unsigned char* lds, const Gemm g, const Sched& S, const Epi& E) {
    int tid_ = threadIdx.x; asm volatile("" : "+v"(tid_));
    const int tid = tid_, wid = __builtin_amdgcn_readfirstlane(tid >> 6), lane = tid & 63, wr = wid >> 2, wc = wid & 3, fr = lane & 15, fq = lane >> 4;
    const int K = g.ldk, nt = g.K / BK; const size_t cstep = (size_t)g.K * 2;
    unsigned voffA[2], voffB[2];
#pragma unroll
    for (int i = 0; i < 2; ++i) { int R, C; stage_rc(tid * 16 + i * 8192, R, C); const int Rb = Epi::PERM ? ((R & ~31) + perm32(R & 31)) : R;
        voffA[i] = (unsigned)(R * K + C) * 2u; voffB[i] = (unsigned)(Rb * K + C) * 2u; }
    const size_t kstep = (size_t)(BK * 2);
    const size_t hstep = (size_t)HALF * K * 2;
    const size_t tstep = 2 * hstep;
    const unsigned ldsw = (unsigned)wid * 1024u;
    const int aoff = lds_byte(wr * 64 + fr, fq * 8), boff = lds_byte(wc * 32 + fr, fq * 8);
#define PG8_SA(b, h) (((b) * 2 + (h)) * HTB)
#define PG8_SB(b, h) ((4 + (b) * 2 + (h)) * HTB)
#define PG8_STAGE(bufoff, gbase, voff) do { _Pragma("unroll") for (int _i = 0; _i < 2; ++_i) \
        __builtin_amdgcn_global_load_lds((const unsigned*)((const char*)(gbase) + (voff)[_i]), (PG8_LAS unsigned*)(lds + (bufoff) + ldsw + _i * 8192), 16, 0, 0); } while (0)
#define PG8_LDA(dst, b, h) do { _Pragma("unroll") for (int m = 0; m < 4; ++m) _Pragma("unroll") for (int k = 0; k < 2; ++k) dst[m][k] = *(const PG8_LAS bf16x8*)(lds + PG8_SA(b, h) + aoff + m * 2048 + k * 1024); } while (0)
#define PG8_LDB(dst, b, h) do { _Pragma("unroll") for (int n = 0; n < 2; ++n) _Pragma("unroll") for (int k = 0; k < 2; ++k) dst[n][k] = *(const PG8_LAS bf16x8*)(lds + PG8_SB(b, h) + boff + n * 2048 + k * 1024); } while (0)
#define PG8_MMA(ai, bj, At, Bt) do { __builtin_amdgcn_s_setprio(1); _Pragma("unroll") for (int m = 0; m < 4; ++m) _Pragma("unroll") for (int n = 0; n < 2; ++n) _Pragma("unroll") for (int k = 0; k < 2; ++k) \
        acc[ai][bj][m][n] = __builtin_amdgcn_mfma_f32_16x16x32_bf16(Bt[n][k], At[m][k], acc[ai][bj][m][n], 0, 0, 0); __builtin_amdgcn_s_setprio(0); } while (0)
#define PG8_WAIT_V(n) asm volatile("s_waitcnt vmcnt(" #n ")" ::: "memory")
#define PG8_WAIT_L(n) asm volatile("s_waitcnt lgkmcnt(" #n ")" ::: "memory")
#define PG8_BAR __builtin_amdgcn_s_barrier()
#define PG8_SCHED __builtin_amdgcn_sched_barrier(0)
    Unit cur, nxt; int ui = 0; int prep_state = -1;
    if (!S.next(0, cur)) return;
    f32x4 acc[2][2][4][2];
#pragma unroll
    for (int a = 0; a < 2; ++a)
#pragma unroll
        for (int b = 0; b < 2; ++b)
#pragma unroll
            for (int m = 0; m < 4; ++m)
#pragma unroll
                for (int n = 0; n < 2; ++n) acc[a][b][m][n] = (f32x4){0.f, 0.f, 0.f, 0.f};
    bf16x8 At[4][2], B0[2][2], B1[2][2];
    const char* cA = (const char*)g.A + (size_t)cur.pm * tstep + (size_t)cur.kc * cstep; const char* cB = (const char*)g.Bt + (size_t)cur.pn * tstep + (size_t)cur.kc * cstep;
    S.a_ready(cur);
    if constexpr (SP2) {
        PG8_STAGE(PG8_SB(0, 0), cB, voffB); PG8_STAGE(PG8_SB(0, 1), cB + hstep, voffB); PG8_STAGE(PG8_SA(0, 0), cA, voffA); PG8_STAGE(PG8_SA(0, 1), cA + hstep, voffA);
        if (wr == 1) PG8_BAR;
        PG8_WAIT_V(2); PG8_BAR;
        PG8_STAGE(PG8_SB(1, 0), cB + kstep, voffB); PG8_STAGE(PG8_SA(1, 0), cA + kstep, voffA); PG8_STAGE(PG8_SB(1, 1), cB + hstep + kstep, voffB);
        PG8_WAIT_V(6); PG8_BAR;
    } else {
        PG8_STAGE(PG8_SB(0, 0), cB, voffB); PG8_STAGE(PG8_SA(0, 0), cA, voffA); PG8_STAGE(PG8_SB(0, 1), cB + hstep, voffB); PG8_STAGE(PG8_SA(0, 1), cA + hstep, voffA);
        if (wr == 1) PG8_BAR;
        PG8_WAIT_V(4); PG8_BAR;
        PG8_STAGE(PG8_SB(1, 0), cB + kstep, voffB); PG8_STAGE(PG8_SA(1, 0), cA + kstep, voffA); PG8_STAGE(PG8_SB(1, 1), cB + hstep + kstep, voffB);
        PG8_WAIT_V(6); PG8_BAR;
    }
    for (;;) {
        const bool has_next = S.next(ui + 1, nxt);
        const char* nA = has_next ? (const char*)g.A + (size_t)nxt.pm * tstep + (size_t)nxt.kc * cstep : cA; const char* nB = has_next ? (const char*)g.Bt + (size_t)nxt.pn * tstep + (size_t)nxt.kc * cstep : cB;
        for (int t = 0; t < nt; t += 2) {
            const bool last = (t == nt - 2);
            const char* a1 = cA + (size_t)(t + 1) * kstep;
            const char* a2 = last ? nA : cA + (size_t)(t + 2) * kstep; const char* b2 = last ? nB : cB + (size_t)(t + 2) * kstep;
            const char* a3 = a2 + kstep; const char* b3 = b2 + kstep;
            if (last && has_next) S.a_ready(nxt);
            if constexpr (Epi::HAS_MID) { if (t == E.mid_t) E.mid(acc, ui, wr, fr); }
            if constexpr (SP2) {
            PG8_LDB(B0, 0, 0); PG8_LDB(B1, 0, 1); PG8_SCHED; PG8_LDA(At, 0, 0); PG8_STAGE(PG8_SA(1, 1), a1 + hstep, voffA);
            PG8_WAIT_V(8); PG8_WAIT_L(0); PG8_BAR; PG8_MMA(0, 0, At, B0); PG8_MMA(0, 1, At, B1); PG8_BAR; PG8_SCHED;
            PG8_LDA(At, 0, 1); PG8_STAGE(PG8_SB(0, 0), b2, voffB); PG8_STAGE(PG8_SB(0, 1), b2 + hstep, voffB); PG8_STAGE(PG8_SA(0, 0), a2, voffA);
            PG8_WAIT_V(8); PG8_WAIT_L(0); PG8_BAR; PG8_MMA(1, 0, At, B0); PG8_MMA(1, 1, At, B1); PG8_BAR; PG8_SCHED;
            PG8_LDB(B0, 1, 0); PG8_LDB(B1, 1, 1); PG8_SCHED; PG8_LDA(At, 1, 0); PG8_STAGE(PG8_SA(0, 1), a2 + hstep, voffA);
            PG8_WAIT_V(8); PG8_WAIT_L(0); PG8_BAR; PG8_MMA(0, 0, At, B0); PG8_MMA(0, 1, At, B1); PG8_BAR; PG8_SCHED;
            PG8_LDA(At, 1, 1); PG8_STAGE(PG8_SB(1, 0), b3, voffB); PG8_STAGE(PG8_SB(1, 1), b3 + hstep, voffB); PG8_STAGE(PG8_SA(1, 0), a3, voffA);
            PG8_WAIT_V(8); PG8_WAIT_L(0); PG8_BAR; PG8_MMA(1, 0, At, B0); PG8_MMA(1, 1, At, B1); PG8_BAR; PG8_SCHED;
            } else {
            PG8_LDB(B0, 0, 0); PG8_SCHED; PG8_LDA(At, 0, 0); PG8_STAGE(PG8_SA(1, 1), a1 + hstep, voffA);
            PG8_WAIT_L(8); PG8_BAR; PG8_WAIT_L(0); PG8_MMA(0, 0, At, B0); PG8_BAR; PG8_SCHED;
            PG8_LDB(B1, 0, 1); PG8_STAGE(PG8_SB(0, 0), b2, voffB);
            PG8_BAR; PG8_WAIT_L(0); PG8_MMA(0, 1, At, B1); PG8_BAR;
            PG8_LDA(At, 0, 1); PG8_STAGE(PG8_SA(0, 0), a2, voffA);
            PG8_BAR; PG8_WAIT_L(0); PG8_MMA(1, 0, At, B0); PG8_BAR; PG8_SCHED;
            PG8_STAGE(PG8_SB(0, 1), b2 + hstep, voffB);
            PG8_WAIT_V(6); PG8_BAR; PG8_MMA(1, 1, At, B1); PG8_BAR;
            PG8_LDB(B0, 1, 0); PG8_SCHED; PG8_LDA(At, 1, 0); PG8_STAGE(PG8_SA(0, 1), a2 + hstep, voffA);
            PG8_WAIT_L(8); PG8_BAR; PG8_WAIT_L(0); PG8_MMA(0, 0, At, B0); PG8_BAR; PG8_SCHED;
            PG8_LDB(B1, 1, 1); PG8_STAGE(PG8_SB(1, 0), b3, voffB);
            PG8_BAR; PG8_WAIT_L(0); PG8_MMA(0, 1, At, B1); PG8_BAR;
            PG8_LDA(At, 1, 1); PG8_STAGE(PG8_SA(1, 0), a3, voffA);
            PG8_BAR; PG8_WAIT_L(0); PG8_MMA(1, 0, At, B0); PG8_BAR; PG8_SCHED;
            PG8_STAGE(PG8_SB(1, 1), b3 + hstep, voffB);
            PG8_WAIT_V(6); PG8_BAR; PG8_MMA(1, 1, At, B1); PG8_BAR;
            }
        }
        if constexpr (ALIGN_EPI) { if (wr == 0) PG8_BAR; }
        if constexpr (Epi::HAS_PREP) { static_assert(ALIGN_EPI, "prep() holds a workgroup barrier: both halves must be aligned"); E.prep(cur, prep_state, tid); }
        if constexpr (!Epi::AFTER_DRAIN) { E(acc, cur, wr, wc, fr, fq); S.done(cur); }
        if (!has_next) break;
#pragma unroll
        for (int a = 0; a < 2; ++a)
#pragma unroll
            for (int b = 0; b < 2; ++b)
#pragma unroll
                for (int m = 0; m < 4; ++m)
#pragma unroll
                    for (int n = 0; n < 2; ++n) acc[a][b][m][n] = (f32x4){0.f, 0.f, 0.f, 0.f};
        cur = nxt; cA = nA; cB = nB; ++ui;
        if constexpr (ALIGN_EPI) { if (wr == 1) PG8_BAR; }
    }
    PG8_WAIT_V(0);
    if constexpr (!ALIGN_EPI) { if (wr == 0) PG8_BAR; }
    PG8_BAR;
    if constexpr (Epi::AFTER_DRAIN) { E.fused(acc, cur, wr, wc, fr, fq, lds, wid, lane); S.done(cur); }
#undef PG8_SA
#undef PG8_SB
#undef PG8_STAGE
#undef PG8_LDA
#undef PG8_LDB
#undef PG8_MMA
#undef PG8_WAIT_V
#undef PG8_WAIT_L
#undef PG8_BAR
#undef PG8_SCHED
}
}
#include <hip/hip_bf16.h>
namespace attp {
using bf16=__hip_bfloat16;
using bf16x8=__attribute__((ext_vector_type(8)))short;
using s16x4=__attribute__((ext_vector_type(4)))short;
using f32x16=__attribute__((ext_vector_type(16)))float;
using u32x4=__attribute__((ext_vector_type(4)))unsigned;
constexpr int D=64,PITCH=3584,QCOL=2048,KCOL=3072,VCOL=3328,MGP=2048;
constexpr int NW=8,QBLK=32,KVBLK=64;
__device__ __forceinline__ int crow(int r,int hi){return (r&3)+8*(r>>2)+4*hi;}
#define SBAR() __builtin_amdgcn_sched_barrier(0)
__device__ __forceinline__ void bmask(f32x16&p0,f32x16&p1,int jb,int qrel,int hi){
  const float NEG=-INFINITY; const int base=64*jb-qrel+4*hi;
  #pragma unroll
  for(int r=0;r<16;++r){const int d=base+(r&3)+8*(r>>2); if(d<0||d>256)p0[r]=NEG; if(d+32<0||d+32>256)p1[r]=NEG;}
}
constexpr int NSLOT=3, SLOTB=8192;
constexpr int LDS_K=0, LDS_V=NSLOT*SLOTB, LDS_WS=2*NSLOT*SLOTB, LDS_OST=LDS_WS+NW*64*4, LDS_BYTES=LDS_OST+NW*4096;
constexpr float C2=0.125f*1.4426950408889634f;
__device__ __forceinline__ void glds16(const void*gsrc,unsigned lds_dst){unsigned keep;
  asm volatile("s_mov_b32 %0, m0\n\ts_mov_b32 m0, %2\n\ts_nop 0\n\tglobal_load_lds_dwordx4 %1, off\n\ts_mov_b32 m0, %0":"=&s"(keep):"v"(gsrc),"s"(lds_dst):"memory");}
__device__ __forceinline__ float max3f(float a,float b,float c){float r;asm("v_max3_f32 %0, %1, %2, %3":"=v"(r):"v"(a),"v"(b),"v"(c));return r;}
__device__ __forceinline__ float max2f(float a,float b){float r;asm("v_max_f32_e32 %0, %1, %2":"=v"(r):"v"(a),"v"(b));return r;}
__device__ __forceinline__ float fadd_s(float a,float b){float r;asm("v_add_f32_e32 %0, %1, %2":"=v"(r):"v"(a),"v"(b));return r;}
__device__ __forceinline__ float fsub_s(float a,float b){float r;asm("v_sub_f32_e32 %0, %1, %2":"=v"(r):"v"(a),"v"(b));return r;}
typedef float f32x2_t __attribute__((ext_vector_type(2))); typedef __bf16 bf16x2_t __attribute__((ext_vector_type(2)));
__device__ __forceinline__ unsigned cvtpk_s(float lo,float hi){f32x2_t v={lo,hi};bf16x2_t b=__builtin_convertvector(v,bf16x2_t);return __builtin_bit_cast(unsigned,b);}
#define WAIT_BAR(N) asm volatile("s_waitcnt vmcnt(" #N ") lgkmcnt(0)\n\ts_barrier":::"memory")

__device__ __forceinline__ void qkt(f32x16&p0,f32x16&p1,const char*Kslot,const bf16x8*qr,const f32x16&negm,int r32,int hi){
  const char*kb=Kslot+hi*1024+r32*16;
  #pragma unroll
  for(int d0=0;d0<4;++d0){
    const bf16x8 b0=*reinterpret_cast<const bf16x8*>(kb+d0*2048);
    const bf16x8 b1=*reinterpret_cast<const bf16x8*>(kb+d0*2048+512);
    if(d0==0){p0=__builtin_amdgcn_mfma_f32_32x32x16_bf16(b0,qr[0],negm,0,0,0);p1=__builtin_amdgcn_mfma_f32_32x32x16_bf16(b1,qr[0],negm,0,0,0);}
    else{p0=__builtin_amdgcn_mfma_f32_32x32x16_bf16(b0,qr[d0],p0,0,0,0);p1=__builtin_amdgcn_mfma_f32_32x32x16_bf16(b1,qr[d0],p1,0,0,0);}}
}
typedef __attribute__((address_space(3))) const char* lds_cptr;
typedef short v4i16_t __attribute__((ext_vector_type(4)));
__device__ __forceinline__ void kload8(bf16x8*kf,lds_cptr kp){
  kf[0]=*(const __attribute__((address_space(3))) bf16x8*)(kp);      kf[1]=*(const __attribute__((address_space(3))) bf16x8*)(kp+512);
  kf[2]=*(const __attribute__((address_space(3))) bf16x8*)(kp+2048); kf[3]=*(const __attribute__((address_space(3))) bf16x8*)(kp+2560);
  kf[4]=*(const __attribute__((address_space(3))) bf16x8*)(kp+4096); kf[5]=*(const __attribute__((address_space(3))) bf16x8*)(kp+4608);
  kf[6]=*(const __attribute__((address_space(3))) bf16x8*)(kp+6144); kf[7]=*(const __attribute__((address_space(3))) bf16x8*)(kp+6656);
}
__device__ __forceinline__ void kload2(bf16x8*kf,lds_cptr kp,int j){ kf[2*j]=*(const __attribute__((address_space(3))) bf16x8*)(kp+j*2048); kf[2*j+1]=*(const __attribute__((address_space(3))) bf16x8*)(kp+j*2048+512); }
__device__ __forceinline__ s16x4 vtr(lds_cptr p){ return __builtin_bit_cast(s16x4,__builtin_amdgcn_ds_read_tr16_b64_v4i16((__attribute__((address_space(3))) v4i16_t*)p)); }
__device__ __forceinline__ float rowmax(const f32x16&p0,const f32x16&p1){
  float a=max3f(p0[0],p0[1],p1[0]),b=max3f(p0[2],p0[3],p1[1]);a=max3f(a,p1[2],p1[3]);
  #pragma unroll
  for(int r=4;r<16;r+=4){a=max3f(a,p0[r],p0[r+1]);b=max3f(b,p0[r+2],p0[r+3]);a=max3f(a,p1[r],p1[r+1]);b=max3f(b,p1[r+2],p1[r+3]);}
  const float m=max2f(a,b);
  auto rr=__builtin_amdgcn_permlane32_swap(__float_as_uint(m),__float_as_uint(m),false,false);
  return max2f(__uint_as_float(rr[0]),__uint_as_float(rr[1]));
}
__device__ __forceinline__ void pv(f32x16*o,int vb,bf16x8 pa0,bf16x8 pa1,bf16x8 pa2,bf16x8 pa3){
  #pragma unroll
  for(int d0=0;d0<2;++d0){s16x4 lo[4],hi[4];
    #pragma unroll
    for(int ks=0;ks<4;++ks){
      asm volatile("ds_read_b64_tr_b16 %0,%1 offset:%c2":"=&v"(lo[ks]):"v"(vb),"i"(d0*4096+ks*1024):"memory");
      asm volatile("ds_read_b64_tr_b16 %0,%1 offset:%c2":"=&v"(hi[ks]):"v"(vb),"i"(d0*4096+ks*1024+512):"memory");}
    asm volatile("s_waitcnt lgkmcnt(0)":::"memory");SBAR();
    #define PK(k) (bf16x8){lo[k][0],lo[k][1],lo[k][2],lo[k][3],hi[k][0],hi[k][1],hi[k][2],hi[k][3]}
    o[d0]=__builtin_amdgcn_mfma_f32_32x32x16_bf16(pa0,PK(0),o[d0],0,0,0);
    o[d0]=__builtin_amdgcn_mfma_f32_32x32x16_bf16(pa1,PK(1),o[d0],0,0,0);
    o[d0]=__builtin_amdgcn_mfma_f32_32x32x16_bf16(pa2,PK(2),o[d0],0,0,0);
    o[d0]=__builtin_amdgcn_mfma_f32_32x32x16_bf16(pa3,PK(3),o[d0],0,0,0);
    #undef PK
  }
}

#ifndef ATTN_STORE16
#define ATTN_STORE16(p,v) (*(u32x4*)(p)=(v))
#endif
struct UnitDesc { int qrow0, hq0, kvh, ctxrow0, bandrow0, jb_lo, jb_hi; };
template<int THRL> __device__ __forceinline__ void attn_unit(const UnitDesc ud,const UnitDesc udn,const bool has_next,const bool pref,bf16x8 (&qr)[4],const bf16*Pb,bf16*MG,float*SSQ,const __attribute__((address_space(3))) float*sink_l2,char*shm){
  int tid_=threadIdx.x; asm volatile("":"+v"(tid_)); const int tid=tid_,lane=tid&63,r32=lane&31,hi=lane>>5; const int wid=__builtin_amdgcn_readfirstlane(tid>>6);
  const int hq=ud.hq0+(wid>>1);
  const bf16*Qw=Pb+(long)(ud.qrow0+(wid&1)*QBLK)*PITCH+QCOL+hq*D;
  const bf16*Kh=Pb+KCOL+ud.kvh*D,*Vh=Pb+VCOL+ud.kvh*D;
  const unsigned lds0=(unsigned)(uintptr_t)shm;
  float*wsf=(float*)(shm+LDS_WS)+wid*64;
  const bf16*ksrc=Kh+(long)lane*PITCH+wid*8;
  const bf16*vsrc=Vh+(long)(16*(wid&3)+(lane>>2))*PITCH+(wid>>2)*32+(lane&3)*8;
  const unsigned kdst=lds0+LDS_K+wid*1024, vdst=lds0+LDS_V+wid*1024;
  const int nb_=ud.jb_hi-ud.jb_lo;
  const int jb_u0=ud.jb_lo>1?ud.jb_lo:1, nun_=(ud.jb_hi<4?ud.jb_hi:4)-jb_u0;
  #define JBF(i) ((i)<nun_?jb_u0+(i):((ud.jb_lo==0&&(i)==nun_)?0:4))
  #define KROW(t) ((long)((t)<4?ud.ctxrow0+64*(t):ud.bandrow0+64*JBF((t)-4)))
  #define DMA_K(t,slot) glds16(ksrc+KROW(t)*PITCH,(unsigned)__builtin_amdgcn_readfirstlane(kdst+(slot)))
  #define DMA_V(t,slot) glds16(vsrc+KROW(t)*PITCH,(unsigned)__builtin_amdgcn_readfirstlane(vdst+(slot)))
  const int vb0=(int)(lds0+LDS_V)+((lane>>4)&1)*32+(lane&3)*8+(4*hi+((lane&15)>>2))*64;
  const char*Kbase=shm+LDS_K; bf16x8 kf[8];
  const lds_cptr shm3=(lds_cptr)shm; const lds_cptr kp0=shm3+LDS_K+hi*1024+r32*16; const lds_cptr vp0=shm3+LDS_V+((lane>>4)&1)*32+(lane&3)*8+(4*hi+((lane&15)>>2))*64;
  const int NT=4+nb_;
  const bool domask=nb_>0;
  if(!pref){
  DMA_K(0,0);DMA_V(0,0);DMA_K(1,SLOTB);
  #pragma unroll
  for(int d0=0;d0<4;++d0)qr[d0]=*reinterpret_cast<const bf16x8*>(&Qw[(long)r32*PITCH+d0*16+hi*8]);
  }
  float mhat=0.f,l_reg=0.f;f32x16 o[2];o[0]=f32x16{};o[1]=f32x16{};f32x16 negm=f32x16{};asm volatile("":"+v"(negm));
  const int qrel=(wid&1)*QBLK+r32;
  #define CMASK(P0,P1,t) do{ if(domask && (t)>=4+nun_) bmask(P0,P1,JBF((t)-4),qrel,hi); }while(0)
  bool resc=false;
  #define START(P0,P1) do{ const float rm=rowmax(P0,P1); resc=false; \
    { const float dl=rm; mhat=fadd_s(mhat,dl); \
      _Pragma("unroll") for(int r=0;r<16;++r){P0[r]=fsub_s(P0[r],dl);P1[r]=fsub_s(P1[r],dl);} \
      _Pragma("unroll") for(int r=0;r<16;++r)negm[r]=-mhat; asm volatile("":"+v"(negm)); } \
    _Pragma("unroll") for(int r=0;r<16;++r)P0[r]=__builtin_amdgcn_exp2f(P0[r]); }while(0)
  #define RESC() do{ if(resc){ asm volatile("s_waitcnt lgkmcnt(0)":::"memory"); \
      _Pragma("unroll") for(int d_=0;d_<2;++d_) _Pragma("unroll") for(int r=0;r<16;++r)o[d_][r]*=wsf[crow(r,hi)]; } }while(0)
  f32x16 pA0,pA1,pB0,pB1;
  int sl_prev=0,sl_cur=0,sl_next=SLOTB;
  #define ROT() do{sl_prev=sl_cur;sl_cur=sl_next;sl_next=(sl_next==(NSLOT-1)*SLOTB)?0:sl_next+SLOTB;}while(0)
  if(!pref){
  DMA_K(2,2*SLOTB);
  WAIT_BAR(3);
  asm volatile("":"+v"(qr[0]),"+v"(qr[1]),"+v"(qr[2]),"+v"(qr[3]));
  } else {
  WAIT_BAR(8);
  }
  qkt(pA0,pA1,Kbase,qr,negm,r32,hi);asm volatile("s_nop 15\n\ts_nop 7":"+v"(pA0),"+v"(pA1));CMASK(pA0,pA1,0);
  START(pA0,pA1);
  _Pragma("unroll") for(int r=0;r<16;++r)pA1[r]=__builtin_amdgcn_exp2f(pA1[r]);
  WAIT_BAR(0);
  DMA_K(3,0);DMA_V(1,SLOTB);
  ROT();
  kload8(kf,kp0+sl_cur);
  WAIT_BAR(2);
  s16x4 vlo[8],vhi[8]; u32x4 pw0,pw1,pw2,pw3;
  #define PKW(P,B) cvtpk_s(P[B],P[B+1])
  #define PAF(k) __builtin_bit_cast(bf16x8,pw##k)
  #define VFR(i) (bf16x8){vlo[i][0],vlo[i][1],vlo[i][2],vlo[i][3],vhi[i][0],vhi[i][1],vhi[i][2],vhi[i][3]}
  #define PIN(x) asm volatile("":"+v"(x))
  #define MX3(a,b,c) __builtin_fmaxf(__builtin_fmaxf((a),(b)),(c))
  #define GAPA(MF,A0,A1,A2,A3,W0,W1,PW) do{ MF; sacc+=A0; sacc+=A1; sacc+=A2; sacc+=A3; PIN(sacc); W0; W1; PIN(PW); SBAR(); }while(0)
  #define EX(v) __builtin_amdgcn_exp2f(v)
  #define GAPB(MF,X,B) do{ MF; X[B]=EX(X[B]); X[B+1]=EX(X[B+1]); X[B+2]=EX(X[B+2]); X[B+3]=EX(X[B+3]); PIN(X); SBAR(); }while(0)
  #define VRD(i) do{ vlo[i]=vtr(vp_+(((i)>>2)*4096+((i)&3)*1024)); vhi[i]=vtr(vp_+(((i)>>2)*4096+((i)&3)*1024+512)); }while(0)
  #define KRD(G,j) do{ if(G){ kload2(kf,kp0+sl_next,j); SBAR(); } }while(0)
  #define STEP(C0,C1,P0,P1,t,GK,GV,GL) do{ SBAR(); \
    const lds_cptr vp_=vp0+sl_prev; \
    VRD(0); SBAR(); float sacc=(P0[0]+P0[1]); \
    GAPA(C0=__builtin_amdgcn_mfma_f32_32x32x16_bf16(kf[0],qr[0],negm,0,0,0), P0[2],P0[3],P0[4],P0[5],     pw0[0]=PKW(P0,0), pw0[1]=PKW(P0,2), pw0); \
    VRD(4); SBAR(); GAPA(C1=__builtin_amdgcn_mfma_f32_32x32x16_bf16(kf[1],qr[0],negm,0,0,0), P0[6],P0[7],P0[8],P0[9],     pw0[2]=PKW(P0,4), pw0[3]=PKW(P0,6), pw0); \
    VRD(1); SBAR(); GAPA(C0=__builtin_amdgcn_mfma_f32_32x32x16_bf16(kf[2],qr[1],C0,0,0,0),   P0[10],P0[11],P0[12],P0[13], pw1[0]=PKW(P0,8), pw1[1]=PKW(P0,10), pw1); \
    VRD(5); SBAR(); GAPA(C1=__builtin_amdgcn_mfma_f32_32x32x16_bf16(kf[3],qr[1],C1,0,0,0),   P0[14],P0[15],P1[0],P1[1],   pw1[2]=PKW(P0,12),pw1[3]=PKW(P0,14), pw1); \
    VRD(2); SBAR(); GAPA(C0=__builtin_amdgcn_mfma_f32_32x32x16_bf16(kf[4],qr[2],C0,0,0,0),   P1[2],P1[3],P1[4],P1[5],     pw2[0]=PKW(P1,0), pw2[1]=PKW(P1,2), pw2); \
    VRD(6); SBAR(); GAPA(C1=__builtin_amdgcn_mfma_f32_32x32x16_bf16(kf[5],qr[2],C1,0,0,0),   P1[6],P1[7],P1[8],P1[9],     pw2[2]=PKW(P1,4), pw2[3]=PKW(P1,6), pw2); \
    VRD(3); SBAR(); GAPA(C0=__builtin_amdgcn_mfma_f32_32x32x16_bf16(kf[6],qr[3],C0,0,0,0),   P1[10],P1[11],P1[12],P1[13], pw3[0]=PKW(P1,8), pw3[1]=PKW(P1,10), pw3); \
    VRD(7); SBAR(); GAPA(C1=__builtin_amdgcn_mfma_f32_32x32x16_bf16(kf[7],qr[3],C1,0,0,0),   P1[14],P1[15],0.f,0.f,       pw3[2]=PKW(P1,12),pw3[3]=PKW(P1,14), pw3); \
    l_reg+=sacc; \
    if(GK){DMA_K((t)+3,sl_cur);} if(GV){DMA_V((t)+1,sl_next);} \
    CMASK(C0,C1,t); \
    { float a=MX3(C0[0],C0[1],C1[0]),b=MX3(C0[2],C0[3],C1[1]); a=MX3(a,C1[2],C1[3]); \
      _Pragma("unroll") for(int r=4;r<16;r+=4){a=MX3(a,C0[r],C0[r+1]);b=MX3(b,C0[r+2],C0[r+3]);a=MX3(a,C1[r],C1[r+1]);b=MX3(b,C1[r+2],C1[r+3]);} \
      float rm=__builtin_fmaxf(a,b); { auto rr=__builtin_amdgcn_permlane32_swap(__float_as_uint(rm),__float_as_uint(rm),false,false); rm=__builtin_fmaxf(__uint_as_float(rr[0]),__uint_as_float(rr[1])); } \
      resc=false; \
      if(__builtin_expect(__any(rm>(float)THRL),0)){ const float dl=__builtin_fmaxf(rm,0.f); mhat+=dl; \
        _Pragma("unroll") for(int r=0;r<16;++r){C0[r]-=dl;C1[r]-=dl;} \
        _Pragma("unroll") for(int r=0;r<16;++r)negm[r]=-mhat; asm volatile("":"+v"(negm)); \
        const float f=__builtin_amdgcn_exp2f(-dl); l_reg*=f; if(hi==0)wsf[r32]=f; resc=true; } } \
    SBAR(); \
    GAPB(o[0]=__builtin_amdgcn_mfma_f32_32x32x16_bf16(PAF(0),VFR(0),o[0],0,0,0), C0,0); \
    GAPB(o[1]=__builtin_amdgcn_mfma_f32_32x32x16_bf16(PAF(0),VFR(4),o[1],0,0,0), C0,4); \
    KRD(GL,0); GAPB(o[0]=__builtin_amdgcn_mfma_f32_32x32x16_bf16(PAF(1),VFR(1),o[0],0,0,0), C0,8); \
    KRD(GL,1); GAPB(o[1]=__builtin_amdgcn_mfma_f32_32x32x16_bf16(PAF(1),VFR(5),o[1],0,0,0), C0,12); \
    KRD(GL,2); GAPB(o[0]=__builtin_amdgcn_mfma_f32_32x32x16_bf16(PAF(2),VFR(2),o[0],0,0,0), C1,0); \
    KRD(GL,3); GAPB(o[1]=__builtin_amdgcn_mfma_f32_32x32x16_bf16(PAF(2),VFR(6),o[1],0,0,0), C1,4); \
    GAPB(o[0]=__builtin_amdgcn_mfma_f32_32x32x16_bf16(PAF(3),VFR(3),o[0],0,0,0), C1,8); \
    GAPB(o[1]=__builtin_amdgcn_mfma_f32_32x32x16_bf16(PAF(3),VFR(7),o[1],0,0,0), C1,12); \
    }while(0)
  int t=1;
  #undef CMASK
  #define CMASK(P0,P1,t) do{}while(0)
  for(;t+4<NT&&t+1<4+nun_;t+=2){
    STEP(pB0,pB1,pA0,pA1,t,true,true,true);     WAIT_BAR(2); RESC(); ROT();
    STEP(pA0,pA1,pB0,pB1,t+1,true,true,true);   WAIT_BAR(2); RESC(); ROT();
  }
  #undef CMASK
  #define CMASK(P0,P1,t) do{ if(domask && (t)>=4+nun_) bmask(P0,P1,JBF((t)-4),qrel,hi); }while(0)
  #define ENDW(tt) do{ if((tt)+3<NT){WAIT_BAR(2);} else if((tt)+2<NT){WAIT_BAR(1);} else {WAIT_BAR(0);} }while(0)
  for(;t+2<NT;t+=2){
    STEP(pB0,pB1,pA0,pA1,t,(t+3<NT),(t+1<NT),(t+1<NT));       ENDW(t);   RESC(); ROT();
    STEP(pA0,pA1,pB0,pB1,t+1,(t+4<NT),(t+2<NT),(t+2<NT));     ENDW(t+1); RESC(); ROT();
  }
  #define DRAIN(Q0,Q1) do{ float sacc=Q0[0]+Q0[1]; _Pragma("unroll") for(int r=2;r<16;++r)sacc+=Q0[r]; _Pragma("unroll") for(int r=0;r<16;++r)sacc+=Q1[r]; l_reg+=sacc; \
    pw0=(u32x4){PKW(Q0,0),PKW(Q0,2),PKW(Q0,4),PKW(Q0,6)};pw1=(u32x4){PKW(Q0,8),PKW(Q0,10),PKW(Q0,12),PKW(Q0,14)};pw2=(u32x4){PKW(Q1,0),PKW(Q1,2),PKW(Q1,4),PKW(Q1,6)};pw3=(u32x4){PKW(Q1,8),PKW(Q1,10),PKW(Q1,12),PKW(Q1,14)}; \
    SBAR(); pv(o,vb0+sl_cur,PAF(0),PAF(1),PAF(2),PAF(3)); }while(0)
  if(t+1<NT){
    STEP(pB0,pB1,pA0,pA1,t,(t+3<NT),(t+1<NT),(t+1<NT));       ENDW(t);   RESC(); ROT();
    pA0=pB0; pA1=pB1;
  }
  STEP(pB0,pB1,pA0,pA1,NT-1,false,false,false); RESC();
  DRAIN(pB0,pB1);
  #undef DRAIN
  asm volatile("s_waitcnt lgkmcnt(0)\n\ts_barrier":::"memory");
  if(has_next){
    const bf16*Khn=Pb+KCOL+udn.kvh*D,*Vhn=Pb+VCOL+udn.kvh*D;
    const bf16*ksn=Khn+(long)lane*PITCH+wid*8, *vsn=Vhn+(long)(16*(wid&3)+(lane>>2))*PITCH+(wid>>2)*32+(lane&3)*8;
    const long r0=(long)udn.ctxrow0;
    glds16(ksn+r0*PITCH,(unsigned)__builtin_amdgcn_readfirstlane(kdst));
    glds16(vsn+r0*PITCH,(unsigned)__builtin_amdgcn_readfirstlane(vdst));
    glds16(ksn+(r0+64)*PITCH,(unsigned)__builtin_amdgcn_readfirstlane(kdst+SLOTB));
    glds16(ksn+(r0+128)*PITCH,(unsigned)__builtin_amdgcn_readfirstlane(kdst+2*SLOTB));
    const bf16*Qn=Pb+(long)(udn.qrow0+(wid&1)*QBLK)*PITCH+QCOL+(udn.hq0+(wid>>1))*D;
    #pragma unroll
    for(int d0=0;d0<4;++d0)qr[d0]=*reinterpret_cast<const bf16x8*>(&Qn[(long)r32*PITCH+d0*16+hi*8]);
  }
  #undef PKW
  #undef PAF
  #undef VFR
  #undef PIN
  #undef MX3
  #undef GAPA
  #undef GAPB
  #undef EX
  #undef VRD
  #undef KRD
  #undef STEP
  #undef ENDW
  {auto rr=__builtin_amdgcn_permlane32_swap(__float_as_uint(l_reg),__float_as_uint(l_reg),false,false);l_reg=__uint_as_float(rr[0])+__uint_as_float(rr[1]);}
  l_reg+=__builtin_amdgcn_exp2f(sink_l2[hq]-mhat);
  if(hi==0)wsf[32+r32]=l_reg;asm volatile("s_waitcnt lgkmcnt(0)":::"memory");
  float rli[16];
  #pragma unroll
  for(int r=0;r<16;++r)rli[r]=__builtin_amdgcn_rcpf(wsf[32+crow(r,hi)]);
  { bf16*stg=(bf16*)(shm+LDS_OST)+wid*2048;
    #pragma unroll
    for(int r=0;r<16;++r){const int orow=crow(r,hi);
      #pragma unroll
      for(int d0=0;d0<2;++d0)stg[orow*64+d0*32+r32]=__float2bfloat16(o[d0][r]*rli[r]);}
    asm volatile("s_waitcnt lgkmcnt(0)":::"memory");
    const long orow0=(long)(ud.qrow0+(wid&1)*QBLK);
    #pragma unroll
    for(int i=0;i<4;++i){const int row=i*8+(lane>>3),ch=lane&7; const u32x4 v=*(const u32x4*)(stg+row*64+ch*8);
      *(u32x4*)(MG+(orow0+row)*MGP+hq*D+ch*8)=v;
      float q=0.f;
      #pragma unroll
      for(int e=0;e<4;++e){const float x0=__uint_as_float(v[e]<<16),x1=__uint_as_float(v[e]&0xffff0000u);q+=x0*x0+x1*x1;}
      q+=__shfl_xor(q,1);q+=__shfl_xor(q,2);q+=__shfl_xor(q,4);
      if(ch==0)SSQ[(orow0+row)*16+hq]=q;} }
  if(has_next) asm volatile("":"+v"(qr[0]),"+v"(qr[1]),"+v"(qr[2]),"+v"(qr[3]));
  #undef DMA_K
  #undef JBF
  #undef KROW
  #undef DMA_V
  #undef CMASK
  #undef START
  #undef RESC
  #undef ROT
}
constexpr int ATTN_LDS_BYTES=LDS_BYTES;
#undef SBAR
#undef WAIT_BAR
}


constexpr int NWAVES = 8;
constexpr int DM = 2048, NBATCH = 2, SEQ = 8192, DEPTH = 4, LCTX = 256;
constexpr int MLAT = NBATCH * SEQ, MCTX = NBATCH * LCTX, MROWS = MLAT + MCTX;
constexpr int NIN = 4608, PP = 3584, FF = 8192, NMODV = 6 * DM;
constexpr float EPS = 1e-6f;
constexpr float QSCALE = 0.125f * 1.4426950408889634f;
constexpr float LOG2E = 1.4426950408889634f;
constexpr size_t MiB = 1u << 20;
constexpr size_t WS_CTL = 0, CTL_ZERO_BYTES = 1 * MiB;
constexpr size_t WS_MOD = 1 * MiB;
constexpr size_t WS_ROPE = 2 * MiB;
constexpr size_t WS_SSQ = 3 * MiB;
constexpr size_t WS_SSQX = 5 * MiB;
constexpr size_t WS_GS = 7 * MiB;
constexpr size_t WS_BIAS = 7 * MiB + 320 * 1024;
constexpr int BIAS_PER_LAYER = 3 * 4608 + 3 * 8192;
constexpr int GS_STAGES = DEPTH * 2 + 1, GS_INV_OFF = GS_STAGES * 2 * 2048;
constexpr size_t WS_WIN = 8 * MiB;
constexpr size_t WS_WOUT = 80 * MiB;
constexpr size_t WS_W1 = 112 * MiB;
constexpr size_t WS_W2 = 240 * MiB;
constexpr size_t WS_X = 368 * MiB;
constexpr size_t WS_H = 500 * MiB;
constexpr size_t WS_P = 566 * MiB;
constexpr size_t WS_MG = 715 * MiB;
constexpr size_t WS_U = 781 * MiB;
constexpr size_t WS_SL1 = 1045 * MiB;
constexpr size_t WS_SL2 = 1077 * MiB;
constexpr size_t WS_END = 1141 * MiB;
constexpr int KS_OUT = 4, KS_MLP2 = 8;
static_assert(WS_MOD + (size_t)DEPTH * 3 * NMODV * 4 <= WS_ROPE && WS_SSQ + (size_t)MROWS * 16 * 4 <= WS_SSQX && WS_SSQX + (size_t)MLAT * 32 * 4 <= WS_GS && WS_GS + (size_t)2 * (DEPTH * 2 + 1) * 2 * DM * 4 <= WS_BIAS && WS_BIAS + (size_t)DEPTH * BIAS_PER_LAYER * 4 <= WS_WIN, "ws map a");
static_assert(WS_WIN + (size_t)DEPTH * NIN * DM * 2 <= WS_WOUT && WS_WOUT + (size_t)DEPTH * DM * DM * 2 <= WS_W1 && WS_W1 + (size_t)DEPTH * FF * DM * 2 <= WS_W2 && WS_W2 + (size_t)DEPTH * FF * DM * 2 <= WS_X, "ws map b");
static_assert(WS_X + (size_t)MROWS * DM * 4 <= WS_H && WS_H + (size_t)MROWS * DM * 2 <= WS_P && WS_P + (size_t)MROWS * NIN * 2 <= WS_MG && WS_MG + (size_t)MROWS * DM * 2 <= WS_U && WS_U + (size_t)MROWS * FF * 2 <= WS_SL1 && WS_SL1 + (size_t)KS_OUT * MCTX * DM * 4 <= WS_SL2 && WS_SL2 + (size_t)KS_MLP2 * MCTX * DM * 4 <= WS_END, "ws map c");
constexpr int CW_CMB = 32768;
constexpr int CW_BAR = 4096;
constexpr int RING_OFF = 0, RING_BYTES = 131072;
constexpr int LDSCTL_OFF = RING_BYTES, MISC_OFF = LDSCTL_OFF + 320;
constexpr int TAB_OFF = RING_BYTES + 1024;
constexpr int LDS_BYTES = 147456;
static_assert(MISC_OFF + 128 <= TAB_OFF && TAB_OFF + 2048 <= LDS_BYTES, "LDS map");

#define GAS __attribute__((address_space(1)))
#define LAS __attribute__((address_space(3)))
typedef unsigned short bf16;
typedef unsigned v4u __attribute__((ext_vector_type(4)));
typedef unsigned v2u __attribute__((ext_vector_type(2)));
typedef float f32x4 __attribute__((ext_vector_type(4)));
typedef GAS unsigned gu32;
#define RLX_AGENT __ATOMIC_RELAXED, __HIP_MEMORY_SCOPE_AGENT
#define LDS_WAIT() asm volatile("s_waitcnt lgkmcnt(0)" ::: "memory")
#define VM_WAIT() asm volatile("s_waitcnt vmcnt(0)" ::: "memory")
__device__ __forceinline__ unsigned f2bf(float f) { unsigned u = __builtin_bit_cast(unsigned, f); return (u + 0x7fffu + ((u >> 16) & 1u)) >> 16; }
__device__ __forceinline__ unsigned pk2(float lo, float hi) { return f2bf(lo) | (f2bf(hi) << 16); }
__device__ __forceinline__ float bflo(unsigned w) { return __uint_as_float(w << 16); }
__device__ __forceinline__ float bfhi(unsigned w) { return __uint_as_float(w & 0xffff0000u); }

#define XB_TMO      128
#define XB_XCNT(j)  (256  + 64 * (j))
#define XB_XSUB(j)  (1280 + 64 * (j))
#define XB_XGEN(j)  (2304 + 64 * (j))
#define XB_TOP      3328
#define XB_TOPGEN   3392
#define XCD_BAR_WORDS 3456
#define XB_SPIN_CAP (1u << 18)

__device__ __forceinline__ unsigned xb_ld(unsigned* p)              { return __hip_atomic_load(p, __ATOMIC_RELAXED, __HIP_MEMORY_SCOPE_AGENT); }
__device__ __forceinline__ unsigned xb_add(unsigned* p, unsigned v) { return __hip_atomic_fetch_add(p, v, __ATOMIC_RELAXED, __HIP_MEMORY_SCOPE_AGENT); }
__device__ __forceinline__ unsigned xb_xcc_id() { return (unsigned)__builtin_amdgcn_s_getreg((3 << 11) | 20) & 0xFu; }
#define XB_SPIN(cond, bar) do { unsigned _sp = 0; while (cond) { __builtin_amdgcn_s_sleep(1); \
    if ((++_sp & 255u) == 0u) { if (xb_ld(&(bar)[XB_TMO])) break; if (_sp > XB_SPIN_CAP) { atomicAdd(&(bar)[XB_TMO], 1u); break; } } } } while (0)

struct XcdBarrier {
    unsigned* bar; unsigned x;
    volatile LAS unsigned* st;
};

__device__ __forceinline__ XcdBarrier xcd_barrier_post(unsigned* bar, volatile LAS unsigned* st) {
    XcdBarrier b; b.bar = bar; b.x = xb_xcc_id(); b.st = st;
    if (threadIdx.x == 0) (void)xb_add(&bar[XB_XCNT(b.x)], 1u);
    return b;
}
__device__ __forceinline__ void xcd_barrier_complete(unsigned* bar, unsigned x, unsigned& nloc, unsigned& nx) {
    const unsigned G = gridDim.x * gridDim.y * gridDim.z;
    unsigned sum, cnt, mine, sp = 0u;
    for (;;) {
        sum = 0u; cnt = 0u; mine = 0u;
#pragma unroll
        for (unsigned j = 0; j < 16; ++j) { const unsigned c = xb_ld(&bar[XB_XCNT(j)]); sum += c; cnt += (c > 0u) ? 1u : 0u; mine = (j == x) ? c : mine; }
        if (sum == G) break;
        __builtin_amdgcn_s_sleep(1);
        if ((++sp & 255u) == 0u) { if (xb_ld(&bar[XB_TMO])) break; if (sp > XB_SPIN_CAP) { atomicAdd(&bar[XB_TMO], 1u); break; } }
    }
    nloc = mine > 0u ? mine : 1u; nx = cnt > 0u ? cnt : 1u;
}

__device__ __forceinline__ void xcd_barrier(const XcdBarrier& b) {
    asm volatile("s_waitcnt vmcnt(0)" ::: "memory");
    __syncthreads();
    if (threadIdx.x == 0) {
        unsigned* bar = b.bar;
        __builtin_amdgcn_s_waitcnt(0);
        unsigned nloc = b.st[0], nx = b.st[1];
        if (nloc == 0u) { xcd_barrier_complete(bar, b.x, nloc, nx); b.st[0] = nloc; b.st[1] = nx; }
        const unsigned old = xb_add(&bar[XB_XSUB(b.x)], 1u);
        const unsigned gen = old / nloc;
        if (old + 1u == (gen + 1u) * nloc) {
            __builtin_amdgcn_fence(__ATOMIC_RELEASE, "agent");
            asm volatile("s_waitcnt vmcnt(0)" ::: "memory");
            const unsigned og = xb_add(&bar[XB_TOP], 1u);
            const unsigned tg = og / nx;
            if (og + 1u == (tg + 1u) * nx) xb_add(&bar[XB_TOPGEN], 1u);
            else XB_SPIN(xb_ld(&bar[XB_TOPGEN]) == tg, bar);
            __builtin_amdgcn_fence(__ATOMIC_ACQUIRE, "agent");
            xb_add(&bar[XB_XGEN(b.x)], 1u);
            asm volatile("s_waitcnt vmcnt(0)" ::: "memory");
        } else {
            XB_SPIN(xb_ld(&bar[XB_XGEN(b.x)]) == gen, bar);
            __builtin_amdgcn_fence(__ATOMIC_ACQUIRE, "agent");
            asm volatile("s_waitcnt vmcnt(0)" ::: "memory");
        }
    }
    __syncthreads();
}
struct Frame {
    LAS unsigned char* lds;
    volatile LAS unsigned* MISC;
    gu32* ctl;
    int tid, lane, wave;
    int vcu, G, bx;
    const float *x, *c, *ctx, *c_ctx, *w_ada, *b_ada, *g_norm1, *g_norm2, *w_in, *conv_w, *conv_b, *sink, *g_out_conv, *g_out_attn, *w_out, *w_mlp1, *w_mlp2, *g_final;
    float* out;
    float *MOD, *ROPE, *SSQ, *X, *SSQX, *GS, *BIAS; bf16 *SL1, *SL2;
    bf16 *WIN, *WOUT, *W1, *W2, *H, *P, *MG, *U;
};

__device__ __forceinline__ float wave_sum(float v) {
#pragma unroll
    for (int o = 1; o < 64; o <<= 1) v += __shfl_xor(v, o);
    return v;
}

__device__ __forceinline__ void p0_transpose_item(const float* W, int K, int N, bf16* WT, LAS float* scr, int item, int lane, bool permqk, const float* kscale = nullptr) {
    const int nblk = N / 32, kb = item / nblk, nb = item % nblk, k0 = 64 * kb, n0 = 32 * nb;
    const int r8 = lane >> 3, c4 = (lane & 7) * 4;
    const bool ilv = permqk && n0 >= 1024 && n0 < 3072, rot = permqk && n0 >= 3072 && n0 < 4352;
    const int g0 = (n0 - 1024) & 255, cb = ((n0 - 1024) >> 8) * 128 + ((g0 >> 5) & 3) * 32 + (g0 >> 7) * 4;
    const int srcc = ilv ? ((c4 < 16 ? 1024 : 2048) + cb + 8 * ((c4 & 15) >> 2)) : n0 + c4;
    f32x4 wv[8];
#pragma unroll
    for (int it = 0; it < 8; ++it) wv[it] = *(const f32x4*)(W + (size_t)(k0 + 8 * it + r8) * N + srcc);
#pragma unroll
    for (int it = 0; it < 8; ++it) { const int kk = 8 * it + r8; f32x4 v = wv[it]; if (kscale && k0 >= K / 2) v *= kscale[k0 + kk - K / 2];
#pragma unroll
        for (int e = 0; e < 4; ++e) { const int lc = c4 + e; const int pc = (ilv || rot) ? (2 * (lc & 15) + (lc >> 4)) : lc; scr[kk * 33 + pc] = v[e]; } }
    const int k0d = kscale ? ((k0 + K / 2) & (K - 1)) : k0;
    LDS_WAIT(); asm volatile("" ::: "memory");
    const int c = lane & 7;
#pragma unroll
    for (int j = 0; j < 4; ++j) { const int n = (lane >> 3) + 8 * j; const LAS float* s = scr + (8 * c) * 33 + n;
        v4u o; o.x = pk2(s[0 * 33], s[1 * 33]); o.y = pk2(s[2 * 33], s[3 * 33]); o.z = pk2(s[4 * 33], s[5 * 33]); o.w = pk2(s[6 * 33], s[7 * 33]);
        *(GAS v4u*)(WT + (size_t)(n0 + n) * K + k0d + 8 * c) = o; }
    LDS_WAIT(); asm volatile("" ::: "memory");
}

constexpr int P0_SCR_BYTES = 64 * 33 * 4;
constexpr int P0_SC_OFF = 8 * P0_SCR_BYTES;
constexpr int P0_PART_OFF = P0_SC_OFF + 3 * DM * 4;
static_assert(P0_PART_OFF + 8 * 3 * 64 * 16 <= RING_BYTES, "prologue LDS");

__device__ __forceinline__ void p0_prologue(Frame& F) {
    {
        LAS float* sc = (LAS float*)(F.lds + P0_SC_OFF);
        for (int i = F.tid; i < 3 * DM; i += NWAVES * 64) { const int v = i / DM, k = i % DM; const float cv = v < 2 ? F.c[v * DM + k] : F.c_ctx[k]; sc[i] = cv / (1.f + __expf(-cv)); }
        __syncthreads();
        LAS f32x4* part = (LAS f32x4*)(F.lds + P0_PART_OFF);
        for (int task = blockIdx.x; task < DEPTH * 48; task += F.G) {
            const int l = task / 48, cg = task % 48;
            const float* W = F.w_ada + (size_t)l * DM * NMODV + cg * 256 + 4 * F.lane;
            const int k0 = F.wave * 256;
            f32x4 a0 = {0.f, 0.f, 0.f, 0.f}, a1 = a0, a2 = a0;
            for (int k = k0; k < k0 + 256; k += 8) {
                f32x4 w[8];
#pragma unroll
                for (int u = 0; u < 8; ++u) w[u] = *(const f32x4*)(W + (size_t)(k + u) * NMODV);
#pragma unroll
                for (int u = 0; u < 8; ++u) { const float s0 = sc[k + u], s1 = sc[DM + k + u], s2 = sc[2 * DM + k + u]; a0 += w[u] * s0; a1 += w[u] * s1; a2 += w[u] * s2; }
            }
            part[(F.wave * 3 + 0) * 64 + F.lane] = a0; part[(F.wave * 3 + 1) * 64 + F.lane] = a1; part[(F.wave * 3 + 2) * 64 + F.lane] = a2;
            __syncthreads();
            if (F.tid < 192) { const int v = F.tid >> 6, ln = F.tid & 63; f32x4 s = part[v * 64 + ln];
#pragma unroll
                for (int w = 1; w < 8; ++w) s += part[(w * 3 + v) * 64 + ln];
                s += *(const f32x4*)(F.b_ada + (size_t)l * NMODV + cg * 256 + 4 * ln);
                *(f32x4*)(F.MOD + (size_t)(l * 3 + v) * NMODV + cg * 256 + 4 * ln) = s; }
            __syncthreads();
        }
    }
    const int gw = F.vcu * NWAVES + F.wave, NGW = F.G * NWAVES;
    {
        const int gt = gw * 64 + F.lane;
        if (gt < 128 * 16) { const int pos = gt >> 4, j = gt & 15;
            const float inv = exp2f(-(float)j * (13.287712379549449f / 16.0f));
            const float angf = (float)pos * inv;
            double a = (double)angf; const double twopi = 6.283185307179586476925; const double kq = __builtin_rint(a / twopi); a -= kq * twopi;
            const double a2 = a * a; double sn = 0.0, cs = 0.0, ts = a, tc = 1.0;
            for (int n = 0; n < 16; ++n) { sn += ts; cs += tc; ts *= -a2 / (double)((2 * n + 2) * (2 * n + 3)); tc *= -a2 / (double)((2 * n + 1) * (2 * n + 2)); }
            F.ROPE[gt * 2] = (float)cs; F.ROPE[gt * 2 + 1] = (float)sn; }
    }
    {
        LAS float* scr = (LAS float*)(F.lds + F.wave * P0_SCR_BYTES);
        constexpr int I_IN = (DM / 64) * (NIN / 32), I_OUT = (DM / 64) * (DM / 32), I_1 = (DM / 64) * (FF / 32), I_2 = (FF / 64) * (DM / 32);
        constexpr int PER_A = I_IN + I_1, TOT = DEPTH * PER_A;
        for (int it = gw; it < TOT; it += NGW) {
            if (it < DEPTH * PER_A) { const int l = it / PER_A; int r = it % PER_A;
                if (r < I_IN) { p0_transpose_item(F.w_in + (size_t)l * DM * NIN, DM, NIN, F.WIN + (size_t)l * NIN * DM, scr, r, F.lane, true); continue; } r -= I_IN;
                p0_transpose_item(F.w_mlp1 + (size_t)l * DM * FF, DM, FF, F.W1 + (size_t)l * FF * DM, scr, r, F.lane, false); continue; }
        }
    }
}
__device__ __forceinline__ void deferred_convert(Frame& F, int l, int first_idle, int nidle) {
    LAS float* scr = (LAS float*)(F.lds + F.wave * P0_SCR_BYTES);
    constexpr int I_OUT = (DM / 64) * (DM / 32), I_2 = (FF / 64) * (DM / 32);
    const int w = (F.bx - first_idle) * NWAVES + F.wave, nw = nidle * NWAVES;
    for (int it = w; it < I_OUT + I_2; it += nw) {
        if (it < I_OUT) p0_transpose_item(F.w_out + (size_t)l * DM * DM, DM, DM, F.WOUT + (size_t)l * DM * DM, scr, it, F.lane, false, F.g_out_attn + (size_t)l * 1024);
        else p0_transpose_item(F.w_mlp2 + (size_t)l * FF * DM, FF, DM, F.W2 + (size_t)l * DM * FF, scr, it - I_OUT, F.lane, false);
    }
}

__device__ __forceinline__ void norm_row(Frame& F, int row, const f32x4* xr, const float* g, const float* modl  , int shift_chunk, const bf16* slab, int nslab) {
    const int mi = row < SEQ ? 0 : (row < MLAT ? 1 : 2);
    f32x4 v[8]; float ss = 0.f;
#pragma unroll
    for (int j = 0; j < 8; ++j) v[j] = xr[64 * j];
    if (row >= MLAT && nslab > 0) {
        for (int kc = 0; kc < nslab; ++kc) { const v2u* sr = (const v2u*)(slab + ((size_t)kc * MCTX + (row - MLAT)) * DM) + F.lane;
#pragma unroll
            for (int j = 0; j < 8; ++j) { const v2u w = sr[64 * j]; v[j] += (f32x4){bflo(w.x), bfhi(w.x), bflo(w.y), bfhi(w.y)}; } }
        f32x4* xw = (f32x4*)(F.X + (size_t)row * DM) + F.lane;
#pragma unroll
        for (int j = 0; j < 8; ++j) xw[64 * j] = v[j];
    }
#pragma unroll
    for (int j = 0; j < 8; ++j) ss += (v[j].x * v[j].x + v[j].y * v[j].y) + (v[j].z * v[j].z + v[j].w * v[j].w);
    const float rstd = 1.0f / sqrtf(wave_sum(ss) * (1.0f / DM) + EPS);
    const f32x4* g4 = (const f32x4*)g + F.lane;
    const f32x4* sh4 = (const f32x4*)(modl + (size_t)mi * NMODV + shift_chunk * DM) + F.lane;
    const f32x4* sc4 = (const f32x4*)(modl + (size_t)mi * NMODV + (shift_chunk + 1) * DM) + F.lane;
    v2u* o8 = (v2u*)(F.H + (size_t)row * DM) + F.lane;
#pragma unroll
    for (int j = 0; j < 8; ++j) { const f32x4 gg = g4[64 * j], sh = sh4[64 * j], sc = sc4[64 * j];
        const f32x4 y = (v[j] * rstd) * gg * (sc + 1.0f) + sh;
        v2u w; w.x = pk2(y.x, y.y); w.y = pk2(y.z, y.w); o8[64 * j] = w; }
}
__device__ __forceinline__ void p0b_phase(Frame& F) {
    const int gw = F.vcu * NWAVES + F.wave, NGW = F.G * NWAVES;
    {
        const int gid = blockIdx.x * (NWAVES * 64) + F.tid;
        if (gid < GS_STAGES * 2 * DM) { const int t = gid >> 12, b = (gid >> 11) & 1, c = gid & (DM - 1); float gsv = 1.0f;
            if (t < 2 * DEPTH) { const int l = t >> 1, j = t & 1;
                const float g = (j ? F.g_norm2 : F.g_norm1)[l * DM + c]; const float sc = F.MOD[(size_t)(l * 3 + b) * NMODV + (j ? 4 : 1) * DM + c];
                gsv = g * (1.0f + sc); if (!(fabsf(gsv) >= 1e-20f)) gsv = (gsv < 0.f) ? -1e-20f : 1e-20f; }
            F.GS[gid] = gsv; F.GS[GS_INV_OFF + gid] = 1.0f / gsv; }
    }
    {
        constexpr int RPL = NIN + FF;
        static_assert((DEPTH * RPL) % (256 * NWAVES) == 0 && RPL % ((DEPTH * RPL) / (256 * NWAVES)) == 0, "bias rows per wave");
        const int per = (DEPTH * RPL) / NGW;
        const int Rb = gw * per, l = Rb / RPL, rb = Rb % RPL;
        const int cnt0 = rb >= NIN ? 0 : ((rb + per <= NIN) ? per : NIN - rb);
        for (int seg = 0; seg < 2; ++seg) {
            const int cnt = seg ? per - cnt0 : cnt0; if (cnt == 0) continue;
            const int mat = seg, n0 = seg ? rb + cnt0 - NIN : rb;
            float sh0[32], sh1[32];
            { const float* m0 = F.MOD + (size_t)(l * 3 + 0) * NMODV + (mat ? 3 : 0) * DM + 8 * F.lane; const float* m1 = m0 + NMODV;
#pragma unroll
                for (int j = 0; j < 4; ++j)
#pragma unroll
                    for (int h4 = 0; h4 < 2; ++h4) { const f32x4 a = *(const f32x4*)(m0 + 512 * j + 4 * h4), b = *(const f32x4*)(m1 + 512 * j + 4 * h4);
#pragma unroll
                        for (int e = 0; e < 4; ++e) { sh0[j * 8 + h4 * 4 + e] = a[e]; sh1[j * 8 + h4 * 4 + e] = b[e]; } } }
            const bf16* wbase = (mat ? F.W1 + (size_t)l * FF * DM : F.WIN + (size_t)l * NIN * DM) + 8 * F.lane;
            float* bo = F.BIAS + (size_t)l * BIAS_PER_LAYER + (mat ? 3 * NIN : 0); const int N = mat ? FF : NIN;
#pragma unroll 1
            for (int i0 = 0; i0 < cnt; i0 += 5) {
                v4u wv[5][4];
#pragma unroll
                for (int q = 0; q < 5; ++q) if (i0 + q < cnt) {
#pragma unroll
                    for (int j = 0; j < 4; ++j) wv[q][j] = *(const v4u*)(wbase + (size_t)(n0 + i0 + q) * DM + 512 * j); }
#pragma unroll
                for (int q = 0; q < 5; ++q) if (i0 + q < cnt) { float s0 = 0.f, s1 = 0.f;
#pragma unroll
                    for (int j = 0; j < 4; ++j)
#pragma unroll
                        for (int e = 0; e < 4; ++e) { const float lo = bflo(wv[q][j][e]), hi = bfhi(wv[q][j][e]);
                            s0 += lo * sh0[j * 8 + 2 * e] + hi * sh0[j * 8 + 2 * e + 1]; s1 += lo * sh1[j * 8 + 2 * e] + hi * sh1[j * 8 + 2 * e + 1]; }
                    s0 = wave_sum(s0); s1 = wave_sum(s1);
                    if (F.lane == 0) { const int n = n0 + i0 + q; bo[n] = s0; bo[N + n] = s1; bo[2 * N + n] = 0.f; } }
            }
        }
    }
    for (int row0 = gw; row0 < MLAT; row0 += 2 * NGW) {
        f32x4 v[2][8];
#pragma unroll
        for (int q = 0; q < 2; ++q) { const f32x4* xr = (const f32x4*)(F.x + (size_t)(row0 + q * NGW) * DM) + F.lane;
#pragma unroll
            for (int j = 0; j < 8; ++j) v[q][j] = xr[64 * j]; }
#pragma unroll
        for (int q = 0; q < 2; ++q) { const int row = row0 + q * NGW; const int b = row >= SEQ ? 1 : 0; float ss = 0.f;
#pragma unroll
            for (int j = 0; j < 8; ++j) ss += (v[q][j].x * v[q][j].x + v[q][j].y * v[q][j].y) + (v[q][j].z * v[q][j].z + v[q][j].w * v[q][j].w);
            ss = wave_sum(ss);
            const f32x4* g4 = (const f32x4*)F.g_norm1 + F.lane; const f32x4* sc4 = (const f32x4*)(F.MOD + (size_t)b * NMODV + DM) + F.lane;
            v2u* o8 = (v2u*)(F.H + (size_t)row * DM) + F.lane;
#pragma unroll
            for (int j = 0; j < 8; ++j) { f32x4 gq = g4[64 * j] * (sc4[64 * j] + 1.0f);
#pragma unroll
                for (int e = 0; e < 4; ++e) if (!(fabsf(gq[e]) >= 1e-20f)) gq[e] = (gq[e] < 0.f) ? -1e-20f : 1e-20f;
                const f32x4 y = v[q][j] * gq; v2u w; w.x = pk2(y.x, y.y); w.y = pk2(y.z, y.w); o8[64 * j] = w; }
            if (F.lane < 32) F.SSQX[(size_t)row * 32 + F.lane] = F.lane == 0 ? ss : 0.f; }
    }
    for (int row = MLAT + gw; row < MROWS; row += NGW) norm_row(F, row, (const f32x4*)(F.ctx + (size_t)(row - MLAT) * DM) + F.lane, F.g_norm1, F.MOD, 0, nullptr, 0);
}
__device__ __forceinline__ void ctx_combine(Frame& F, int nsub, gu32* cnt, const float* xsrc  , const float* g, const float* modl, int shift_chunk, const bf16* slab, int nslab) {
    if ((int)blockIdx.x >= nsub) return;
    VM_WAIT(); __syncthreads();
    if (F.tid == 0) {
        __builtin_amdgcn_fence(__ATOMIC_RELEASE, "agent"); VM_WAIT();
        __hip_atomic_fetch_add(cnt, 1u, RLX_AGENT);
        unsigned sp = 0;
        while (__hip_atomic_load(cnt, RLX_AGENT) < (unsigned)nsub) { __builtin_amdgcn_s_sleep(2); if (++sp > (1u << 20)) { __hip_atomic_store(F.ctl + 1, 0xC0DEu, RLX_AGENT); break; } }
        __builtin_amdgcn_fence(__ATOMIC_ACQUIRE, "agent"); VM_WAIT();
    }
    __syncthreads();
    const int rpc = MCTX / nsub;
    for (int r = F.wave; r < rpc; r += NWAVES) { const int row = MLAT + (int)blockIdx.x * rpc + r;
        norm_row(F, row, (const f32x4*)(xsrc + (size_t)(row - MLAT) * DM) + F.lane, g, modl, shift_chunk, slab, nslab); }
}
__device__ __forceinline__ void final_norm_phase(Frame& F) {
    const int gw = F.vcu * NWAVES + F.wave, NGW = F.G * NWAVES;
    const f32x4* g4 = (const f32x4*)F.g_final + F.lane;
    for (int row0 = gw; row0 < MLAT; row0 += 4 * NGW) {
        v2u w[4][8];
#pragma unroll
        for (int q = 0; q < 4; ++q) { const v2u* xr = (const v2u*)(F.H + (size_t)(row0 + q * NGW) * DM) + F.lane;
#pragma unroll
            for (int j = 0; j < 8; ++j) w[q][j] = xr[64 * j]; }
#pragma unroll
        for (int q = 0; q < 4; ++q) { f32x4 v[8]; float ss = 0.f;
#pragma unroll
            for (int j = 0; j < 8; ++j) { v[j] = (f32x4){bflo(w[q][j].x), bfhi(w[q][j].x), bflo(w[q][j].y), bfhi(w[q][j].y)}; ss += (v[j].x * v[j].x + v[j].y * v[j].y) + (v[j].z * v[j].z + v[j].w * v[j].w); }
            const float rstd = 1.0f / sqrtf(wave_sum(ss) * (1.0f / DM) + EPS);
            f32x4* o = (f32x4*)(F.out + (size_t)(row0 + q * NGW) * DM) + F.lane;
#pragma unroll
            for (int j = 0; j < 8; ++j) o[64 * j] = (v[j] * rstd) * g4[64 * j]; }
    }
}
__device__ __forceinline__ void conv_phase(Frame& F, int layer, int nrows) {
    const int gw = F.vcu * NWAVES + F.wave, NGW = F.G * NWAVES;
    const float* cw = F.conv_w + (size_t)layer * 3 * 1024; const float* cb = F.conv_b + (size_t)layer * 1024; const float* go = F.g_out_conv + (size_t)layer * 1024;
    float w0[16], w1[16], w2[16], bb[16], gg[16];
#pragma unroll
    for (int hh = 0; hh < 2; ++hh)
#pragma unroll
        for (int q4 = 0; q4 < 2; ++q4) { const int ch = hh * 512 + 8 * F.lane + 4 * q4;
            const f32x4 a0 = *(const f32x4*)(cw + ch), a1 = *(const f32x4*)(cw + 1024 + ch), a2 = *(const f32x4*)(cw + 2048 + ch), a3 = *(const f32x4*)(cb + ch), a4 = *(const f32x4*)(go + ch);
#pragma unroll
            for (int e = 0; e < 4; ++e) { const int k = hh * 8 + q4 * 4 + e; w0[k] = a0[e]; w1[k] = a1[e]; w2[k] = a2[e]; bb[k] = a3[e]; gg[k] = a4[e]; } }
    for (int run = NGW - 1 - gw; run < nrows / 8; run += NGW) {
        const int r0 = run * 8;
        const bool seq_start = (r0 == 0) || (r0 == SEQ) || (r0 == MLAT) || (r0 == MLAT + LCTX);
        const int rend = r0 + 8;
        const bool seq_end = (rend == SEQ) || (rend == MLAT) || (rend == MLAT + LCTX) || (rend == MROWS);
#pragma unroll 1
        for (int h = 0; h < 2; ++h) {
            const int a = r0 + 4 * h;
            v4u ur[6][2], br[4][2];
#pragma unroll
            for (int j = 0; j < 6; ++j) {
                const bool valid = !((j == 0 && h == 0 && seq_start) || (j == 5 && h == 1 && seq_end));
                const bf16* pr_ = F.P + (size_t)(a - 1 + j) * PP + 8 * F.lane + 1024;
#pragma unroll
                for (int hh = 0; hh < 2; ++hh) { if (valid) ur[j][hh] = *(const v4u*)(pr_ + hh * 512); else ur[j][hh] = (v4u){0u, 0u, 0u, 0u}; }
            }
#pragma unroll
            for (int i = 0; i < 4; ++i) { const bf16* pr = F.P + (size_t)(a + i) * PP + 8 * F.lane;
#pragma unroll
                for (int hh = 0; hh < 2; ++hh) br[i][hh] = *(const v4u*)(pr + hh * 512); }
#pragma unroll
            for (int i = 0; i < 4; ++i) {
                const int row = a + i;
                float y[16]; float ss = 0.f;
#pragma unroll
                for (int hh = 0; hh < 2; ++hh) {
#pragma unroll
                    for (int e = 0; e < 8; ++e) {
                        const unsigned wp = ur[i][hh][e >> 1], wc_ = ur[i + 1][hh][e >> 1], wn = ur[i + 2][hh][e >> 1], wb = br[i][hh][e >> 1];
                        const float up = (e & 1) ? bfhi(wp) : bflo(wp), uc = (e & 1) ? bfhi(wc_) : bflo(wc_), un = (e & 1) ? bfhi(wn) : bflo(wn), bg = (e & 1) ? bfhi(wb) : bflo(wb);
                        const int k = hh * 8 + e;
                        const float cv = up * w0[k] + uc * w1[k] + un * w2[k] + bb[k];
                        y[k] = bg * cv; ss += y[k] * y[k];
                    }
                }
                const float rstd = 1.0f / sqrtf(wave_sum(ss) * (1.0f / 1024.0f) + EPS);
                bf16* mo = F.MG + (size_t)row * DM + 1024 + 8 * F.lane;
#pragma unroll
                for (int hh = 0; hh < 2; ++hh) { v4u w;
#pragma unroll
                    for (int e = 0; e < 4; ++e) w[e] = pk2(y[hh * 8 + 2 * e] * rstd * gg[hh * 8 + 2 * e], y[hh * 8 + 2 * e + 1] * rstd * gg[hh * 8 + 2 * e + 1]);
                    *(v4u*)(mo + hh * 512) = w; }
            }
        }
    }
}
__device__ __forceinline__ void attn_rstd_table(Frame& F, int pm, LAS float* tab) {
    const int row = F.tid >> 1, half = F.tid & 1;
    const f32x4* q4 = (const f32x4*)(F.SSQ + (size_t)(pm * 256 + row) * 16 + half * 8);
    const f32x4 a = q4[0], b = q4[1];
    float q = ((a.x + a.y) + (a.z + a.w)) + ((b.x + b.y) + (b.z + b.w));
    q += __shfl_xor(q, 1);
    if (half == 0) tab[row] = 1.0f / sqrtf(q * (1.0f / 1024.0f) + EPS);
}
__device__ __forceinline__ void attention_phase(Frame& F, int layer, bool with_ctx) {
    LAS float* sk = (LAS float*)(F.lds + RING_OFF + attp::LDS_BYTES);
    if (F.tid < 16) sk[F.tid] = F.sink[layer * 16 + F.tid] * LOG2E;
    __syncthreads();
    const int NU = 1024 + (with_ctx ? 32 : 0);
    auto unit_desc = [](int u) { attp::UnitDesc ud;
        if (u < 1024) { const int kvh = u & 3, nb = (u >> 2) & 127, b = u >> 9;
            ud.qrow0 = b * SEQ + nb * 64; ud.hq0 = kvh * 4; ud.kvh = kvh; ud.ctxrow0 = MLAT + b * LCTX; ud.bandrow0 = b * SEQ + nb * 64 - 128;
            ud.jb_lo = nb < 2 ? 2 - nb : 0; ud.jb_hi = nb > 125 ? 130 - nb : 5; }
        else { const int v = u - 1024; const int kvh = v & 3, qb = (v >> 2) & 3, b = v >> 4;
            ud.qrow0 = MLAT + b * LCTX + qb * 64; ud.hq0 = kvh * 4; ud.kvh = kvh; ud.ctxrow0 = MLAT + b * LCTX; ud.bandrow0 = 0; ud.jb_lo = 0; ud.jb_hi = 0; }
        return ud; };
    attp::bf16x8 qr[4]; bool pref = false;
    for (int u = F.vcu; u < NU; u += F.G) {
        const bool has_next = u + F.G < NU;
        const attp::UnitDesc ud = unit_desc(u), udn = unit_desc(has_next ? u + F.G : u);
        attp::attn_unit<8>(ud, udn, has_next, pref, qr, (const attp::bf16*)F.P, (attp::bf16*)F.MG, F.SSQ, sk, (char*)(F.lds + RING_OFF));
        pref = has_next;
    }
}

struct Args { const float* in[18]; float* out; unsigned char* ws; int ph_lo, ph_hi; };
constexpr int PH_PER_LAYER = 7, PH_TOTAL = 2 + DEPTH * PH_PER_LAYER + 1;

typedef __attribute__((address_space(4))) const Args* KArgs;
__device__ __forceinline__ void build_frame(Frame& F, unsigned char* lds) {
    KArgs ap = (KArgs)__builtin_amdgcn_kernarg_segment_ptr(); asm volatile("" : "+s"(ap));
    int tid = threadIdx.x; asm volatile("" : "+v"(tid));
    F.lds = (LAS unsigned char*)lds;
    F.MISC = (volatile LAS unsigned*)(F.lds + MISC_OFF);
    F.tid = tid; F.lane = tid & 63; F.wave = __builtin_amdgcn_readfirstlane(tid >> 6);
    F.G = gridDim.x; { int bx = blockIdx.x; asm volatile("" : "+s"(bx)); F.bx = bx; F.vcu = (bx & 7) * (F.G >> 3) + (bx >> 3); }
    unsigned char* ws = ap->ws;
    F.ctl = (gu32*)(ws + WS_CTL);
    F.x = ap->in[0]; F.c = ap->in[1]; F.ctx = ap->in[2]; F.c_ctx = ap->in[3]; F.w_ada = ap->in[4]; F.b_ada = ap->in[5]; F.g_norm1 = ap->in[6]; F.g_norm2 = ap->in[7];
    F.w_in = ap->in[8]; F.conv_w = ap->in[9]; F.conv_b = ap->in[10]; F.sink = ap->in[11]; F.g_out_conv = ap->in[12]; F.g_out_attn = ap->in[13]; F.w_out = ap->in[14];
    F.w_mlp1 = ap->in[15]; F.w_mlp2 = ap->in[16]; F.g_final = ap->in[17]; F.out = ap->out;
    F.MOD = (float*)(ws + WS_MOD); F.ROPE = (float*)(ws + WS_ROPE); F.SSQ = (float*)(ws + WS_SSQ); F.X = (float*)(ws + WS_X); F.SL1 = (bf16*)(ws + WS_SL1); F.SL2 = (bf16*)(ws + WS_SL2); F.SSQX = (float*)(ws + WS_SSQX); F.GS = (float*)(ws + WS_GS); F.BIAS = (float*)(ws + WS_BIAS);
    F.WIN = (bf16*)(ws + WS_WIN); F.WOUT = (bf16*)(ws + WS_WOUT); F.W1 = (bf16*)(ws + WS_W1); F.W2 = (bf16*)(ws + WS_W2);
    F.H = (bf16*)(ws + WS_H); F.P = (bf16*)(ws + WS_P); F.MG = (bf16*)(ws + WS_MG); F.U = (bf16*)(ws + WS_U);
}

__global__ void __launch_bounds__(NWAVES * 64, 2) mk_fwd(Args args) {
    extern __shared__ __attribute__((aligned(16))) unsigned char lds[];
    for (int u = threadIdx.x; u < (LDS_BYTES - LDSCTL_OFF) / 4; u += NWAVES * 64) ((LAS unsigned*)((LAS unsigned char*)lds + LDSCTL_OFF))[u] = 0u;
    __syncthreads();
    XcdBarrier bar = xcd_barrier_post((unsigned*)(args.ws + WS_CTL) + CW_BAR, (volatile LAS unsigned*)((LAS unsigned char*)lds + MISC_OFF) + 8);

    const int lo = args.ph_lo, hi = args.ph_hi;
    int ph = 0;
#define IN_RANGE(k) (lo <= (k) && (k) < hi)
#define SEAM(k) do { if (IN_RANGE(k) && IN_RANGE((k) + 1)) xcd_barrier(bar); } while (0)

    asm volatile("; MARK_P0");
    if (IN_RANGE(ph)) { Frame F; build_frame(F, lds); p0_prologue(F); }
    SEAM(ph); ++ph;
    asm volatile("; MARK_P0B");
    if (IN_RANGE(ph)) { Frame F; build_frame(F, lds); p0b_phase(F); }
    SEAM(ph); ++ph;

    for (int layer = 0; layer < DEPTH; ++layer) {
        const bool last = (layer == DEPTH - 1);
        const int mrows = last ? MLAT : MROWS;
        asm volatile("; MARK_L2");
        if (IN_RANGE(ph)) { Frame F; build_frame(F, lds);
            pg8::Gemm g{F.H, F.WIN + (size_t)layer * NIN * DM, MROWS, NIN, DM, DM}; pg8::StaticOrder S; S.init(MROWS, NIN, F.G, F.bx);
            pg8::EpiIn E{F.P, PP, F.ROPE, QSCALE, MLAT / 256, pg8::NormFold{F.SSQX, F.BIAS + (size_t)layer * BIAS_PER_LAYER, NIN, (LAS float*)(F.lds + TAB_OFF), 1.0f / DM, EPS}};
            pg8::gemm_phase<pg8::EpiIn, pg8::StaticOrder, true, true>(F.lds + RING_OFF, g, S, E);
            constexpr int NU_L2 = (MROWS / 256) * (NIN / 256), FIRST_IDLE = NU_L2 % 256;
            if (F.bx >= FIRST_IDLE) deferred_convert(F, layer, FIRST_IDLE, 256 - FIRST_IDLE);
        }
        SEAM(ph); ++ph;
        asm volatile("; MARK_L3");
        if (IN_RANGE(ph)) { { Frame F; build_frame(F, lds); attention_phase(F, layer, !last); } { Frame F; build_frame(F, lds); conv_phase(F, layer, mrows); } }
        SEAM(ph); ++ph;
        asm volatile("; MARK_L4");
        if (IN_RANGE(ph)) { Frame F; build_frame(F, lds);
            pg8::Gemm g{F.MG, F.WOUT + (size_t)layer * DM * DM, MLAT, DM, DM, DM}; pg8::StaticOrder S; S.init(MLAT, DM, F.G, F.bx);
            LAS float* tab = (LAS float*)(F.lds + TAB_OFF);
            { pg8::Unit u; if (S.next(0, u)) attn_rstd_table(F, u.pm, tab); if (S.next(1, u)) attn_rstd_table(F, u.pm, tab + 256); }
            __syncthreads();
            pg8::EpiRes<true> E{F.H, DM, F.MOD + (size_t)layer * 3 * NMODV + 2 * DM, NMODV, DM / 128  , tab,
                                 F.GS + GS_INV_OFF + (size_t)(2 * layer) * 2 * DM  , F.GS + (size_t)(2 * layer + 1) * 2 * DM  , F.SSQX};
            pg8::gemm_phase<pg8::EpiRes<true>, pg8::StaticOrder, true, true>(F.lds + RING_OFF, g, S, E);
        }
        if (IN_RANGE(ph) && !last) { Frame F; build_frame(F, lds);
            pg8::Gemm g{F.MG, F.WOUT + (size_t)layer * DM * DM, MROWS, DM, DM / KS_OUT, DM}; pg8::SplitOrder S; S.init(MLAT / 256, MCTX / 256, DM / 256, KS_OUT, F.G, F.bx);
            LAS float* tab = (LAS float*)(F.lds + TAB_OFF);
            __syncthreads();
            { pg8::Unit u; if (S.next(0, u)) attn_rstd_table(F, u.pm, tab); }
            __syncthreads();
            pg8::EpiSlab E{F.SL1, DM, F.MOD + (size_t)layer * 3 * NMODV + 2 * NMODV + 2 * DM, MLAT / 256, MCTX, KS_OUT / 2, tab};
            pg8::gemm_phase<pg8::EpiSlab, pg8::SplitOrder, true, true>(F.lds + RING_OFF, g, S, E);
        }
        if (IN_RANGE(ph) && !last) { Frame F; build_frame(F, lds);
            ctx_combine(F, (MCTX / 256) * (DM / 256) * KS_OUT, F.ctl + CW_CMB + 64 * (2 * layer), layer == 0 ? F.ctx : F.X + (size_t)MLAT * DM, F.g_norm2 + (size_t)layer * DM, F.MOD + (size_t)layer * 3 * NMODV, 3, F.SL1, KS_OUT);
        }
        SEAM(ph); ++ph;
        for (int hv = 0; hv < 2; ++hv) {
            const int pm0 = hv * (SEQ / 256);
            const int m6 = SEQ + ((hv == 1 && !last) ? MCTX : 0);
            asm volatile("; MARK_L6");
            if (IN_RANGE(ph)) { Frame F; build_frame(F, lds);
                bf16* Ub = F.U - (size_t)hv * SEQ * FF;
                pg8::Gemm g{F.H, F.W1 + (size_t)layer * FF * DM, m6, FF, DM, DM}; pg8::StaticOrder S; S.init(m6, FF, F.G, F.bx, pm0);
                pg8::EpiSq E{Ub, FF, pg8::NormFold{F.SSQX, F.BIAS + (size_t)layer * BIAS_PER_LAYER + 3 * NIN, FF, (LAS float*)(F.lds + TAB_OFF), 1.0f / DM, EPS}};
                pg8::gemm_phase<pg8::EpiSq, pg8::StaticOrder, true, true>(F.lds + RING_OFF, g, S, E);
            }
            SEAM(ph); ++ph;
            asm volatile("; MARK_L7");
            if (IN_RANGE(ph)) { Frame F; build_frame(F, lds);
                const bf16* Ub = F.U - (size_t)hv * SEQ * FF;
                pg8::Gemm g{Ub, F.W2 + (size_t)layer * DM * FF, SEQ, DM, FF, FF}; pg8::StaticOrder S; S.init(SEQ, DM, F.G, F.bx, pm0);
                pg8::EpiRes<false> E{F.H, DM, F.MOD + (size_t)layer * 3 * NMODV + 5 * DM, NMODV, -1, nullptr,
                                      F.GS + GS_INV_OFF + (size_t)(2 * layer + 1) * 2 * DM  , F.GS + (size_t)(2 * layer + 2) * 2 * DM  , F.SSQX};
                pg8::gemm_phase<pg8::EpiRes<false>, pg8::StaticOrder, true, true>(F.lds + RING_OFF, g, S, E);
            }
            if (IN_RANGE(ph) && !last && hv == 1) { Frame F; build_frame(F, lds);
                const bf16* Ub = F.U - (size_t)SEQ * FF;
                pg8::Gemm g{Ub, F.W2 + (size_t)layer * DM * FF, MROWS, DM, FF / KS_MLP2, FF}; pg8::SplitOrder S; S.init(MLAT / 256, MCTX / 256, DM / 256, KS_MLP2, F.G, F.bx);
                pg8::EpiSlab E{F.SL2, DM, F.MOD + (size_t)layer * 3 * NMODV + 2 * NMODV + 5 * DM, MLAT / 256, MCTX, 0, nullptr};
                pg8::gemm_phase<pg8::EpiSlab, pg8::SplitOrder, true, true>(F.lds + RING_OFF, g, S, E);
            }
            if (IN_RANGE(ph) && !last && hv == 1) { Frame F; build_frame(F, lds);
                ctx_combine(F, (MCTX / 256) * (DM / 256) * KS_MLP2, F.ctl + CW_CMB + 64 * (2 * layer + 1), F.X + (size_t)MLAT * DM, F.g_norm1 + (size_t)(layer + 1) * DM, F.MOD + (size_t)(layer + 1) * 3 * NMODV, 0, F.SL2, KS_MLP2);
            }
            SEAM(ph); ++ph;
        }
    }
    asm volatile("; MARK_FIN");
    if (IN_RANGE(ph)) { Frame F; build_frame(F, lds); final_norm_phase(F); }
#undef IN_RANGE
#undef SEAM
}

#ifndef MK_CUTS
#define MK_CUTS 0
#endif
extern "C" void kernel_launch(void* const* d_in, const int* in_sizes, int n_in, void* d_out, int out_size, void* d_ws, size_t ws_size, hipStream_t stream) {
    static int grid = 0;
    if (grid == 0) {
        if (n_in != 18 || in_sizes[0] != MLAT * DM || out_size != MLAT * DM || ws_size < WS_END) { fprintf(stderr, "kernel_launch: unexpected shapes (n_in %d, in0 %d, out %d, ws %zu); nothing launched\n", n_in, n_in > 0 ? in_sizes[0] : -1, out_size, ws_size); grid = -1; return; }
        int dev = 0, cus = 0, per_cu = 0;
        if (hipGetDevice(&dev) != hipSuccess || hipDeviceGetAttribute(&cus, hipDeviceAttributeMultiprocessorCount, dev) != hipSuccess) { fprintf(stderr, "kernel_launch: device query failed\n"); grid = -1; return; }
        if (hipFuncSetAttribute((const void*)mk_fwd, hipFuncAttributeMaxDynamicSharedMemorySize, LDS_BYTES) != hipSuccess) { fprintf(stderr, "kernel_launch: hipFuncSetAttribute failed\n"); grid = -1; return; }
        if (hipOccupancyMaxActiveBlocksPerMultiprocessor(&per_cu, (const void*)mk_fwd, NWAVES * 64, LDS_BYTES) != hipSuccess || per_cu < 1)
            fprintf(stderr, "kernel_launch: note: occupancy query reports %d workgroups per CU\n", per_cu);
        (void)hipGetLastError();
        grid = cus;
        if (grid != 256) { fprintf(stderr, "kernel_launch: built for a 256-CU device (whole GEMM rounds, one context sub-unit per workgroup); found %d CUs; nothing launched\n", cus); grid = -1; return; }
    }
    if (grid < 0) return;
    if (hipMemsetAsync((char*)d_ws + WS_CTL, 0, CTL_ZERO_BYTES, stream) != hipSuccess) { fprintf(stderr, "kernel_launch: memset failed\n"); return; }
    Args a{};
    for (int i = 0; i < 18; ++i) a.in[i] = (const float*)d_in[i];
    a.out = (float*)d_out; a.ws = (unsigned char*)d_ws;
#if MK_CUTS
    for (int p = 0; p < PH_TOTAL; ++p) { a.ph_lo = p; a.ph_hi = p + 1; hipLaunchKernelGGL(mk_fwd, dim3(grid), dim3(NWAVES * 64), LDS_BYTES, stream, a); }
#else
    a.ph_lo = 0; a.ph_hi = PH_TOTAL;
    hipLaunchKernelGGL(mk_fwd, dim3(grid), dim3(NWAVES * 64), LDS_BYTES, stream, a);
#endif
    const hipError_t le = hipPeekAtLastError();
    if (le != hipSuccess) fprintf(stderr, "kernel_launch: launch failed: %s\n", hipGetErrorName(le));
}
```
